# Optimizing an MI355X kernel written in HIP

```python
import math
import jax, jax.numpy as jnp
from jax import lax
import numpy as np

D_MODEL = 1024
BATCH = 8
SEQ = 4096
DEPTH = 2

HEAD_DIM = 64
ROPE_THETA = 10000.0
EPS = 1e-6
N_MIXERS = 2
DIL_GROUPS = ((128, 1), (512, 4), (2048, 16))
N_DIL_GROUPS = len(DIL_GROUPS)
DIL_HEADS = D_MODEL // HEAD_DIM
DIL_WIDTH = DIL_HEADS * HEAD_DIM
DIL_IN = 3 * N_DIL_GROUPS * DIL_WIDTH + DIL_WIDTH
DIFF_HEADS = D_MODEL // HEAD_DIM // 2
DIFF_QK_DIM = HEAD_DIM
DIFF_V_DIM = 2 * HEAD_DIM
DIFF_WIDTH = DIFF_HEADS * DIFF_V_DIM
DIFF_QK_WIDTH = 2 * DIFF_HEADS * DIFF_QK_DIM
DIFF_IN = 2 * DIFF_QK_WIDTH + 2 * DIFF_WIDTH
Q_BLOCK = 128
N_DIL_LAYERS = (DEPTH + 1) // 2
N_DIFF_LAYERS = DEPTH // 2

kernel_name = "hybrid_dilated_diff_attention_trunk"


def rmsnorm(x, g):
    x32 = x.astype(jnp.float32)
    y = x32 * lax.rsqrt(jnp.mean(x32 * x32, axis=-1, keepdims=True) + EPS)
    return y.astype(x.dtype) * g


def rope(x, pos):
    dh = x.shape[-1]
    freqs = ROPE_THETA ** (-jnp.arange(0, dh, 2, dtype=jnp.float32) / dh)
    ang = pos.astype(jnp.float32)[:, None] * freqs[None, :]
    cos = jnp.cos(ang)[None, :, None, :].astype(x.dtype)
    sin = jnp.sin(ang)[None, :, None, :].astype(x.dtype)
    x1, x2 = x[..., : dh // 2], x[..., dh // 2:]
    return jnp.concatenate([x1 * cos - x2 * sin, x2 * cos + x1 * sin], axis=-1)


def dilated_window_attention(q, k, v, window, dilation):
    B, S, H, Dh = q.shape
    w = window // dilation
    L = S // dilation
    nb = -(-L // w)
    Lp = nb * w

    def to_sub(t):
        t = t.reshape(B, L, dilation, H, Dh).transpose(0, 2, 1, 3, 4)
        t = jnp.pad(t, ((0, 0), (0, 0), (0, Lp - L), (0, 0), (0, 0)))
        return t.reshape(B, dilation, nb, w, H, Dh)

    qs, ks, vs = to_sub(q), to_sub(k), to_sub(v)

    def with_prev(t):
        prev = jnp.pad(t, ((0, 0), (0, 0), (1, 0), (0, 0), (0, 0), (0, 0)))[:, :, :-1]
        return jnp.concatenate([prev, t], axis=3)

    kb, vb = with_prev(ks), with_prev(vs)
    scores = jnp.einsum('brnqhd,brnkhd->brnhqk', qs, kb).astype(jnp.float32) * (Dh ** -0.5)
    qi = jnp.arange(w)[:, None]
    kj = jnp.arange(2 * w)[None, :]
    dist = w + qi - kj
    kpos = jnp.arange(nb)[:, None, None] * w + kj[None] - w
    mask = (dist >= 0)[None] & (dist <= w)[None] & (kpos >= 0)
    scores = jnp.where(mask[None, None, :, None], scores, -jnp.inf)
    m = jnp.max(scores, axis=-1, keepdims=True)
    p = jnp.exp(scores - m)
    den = jnp.sum(p, axis=-1)
    out = jnp.einsum('brnhqk,brnkhd->brnhqd', p.astype(v.dtype), vb).astype(jnp.float32)
    out = out / den[..., None]
    lse = m[..., 0] + jnp.log(den)
    out = out.transpose(0, 1, 2, 4, 3, 5).reshape(B, dilation, Lp, H, Dh)[:, :, :L]
    out = out.transpose(0, 2, 1, 3, 4).reshape(B, S, H, Dh)
    lse = lse.transpose(0, 1, 2, 4, 3).reshape(B, dilation, Lp, H)[:, :, :L]
    lse = lse.transpose(0, 2, 1, 3).reshape(B, S, H)
    return out, lse


def dilated_mixer(h, w_in, w_out):
    B, S, _ = h.shape
    pos = jnp.arange(S)
    proj = h @ w_in
    n_qkv = 3 * N_DIL_GROUPS * DIL_WIDTH
    qkv = proj[..., :n_qkv].reshape(B, S, 3, N_DIL_GROUPS * DIL_HEADS, HEAD_DIM)
    gate = proj[..., n_qkv:]
    q = rope(qkv[:, :, 0], pos)
    k = rope(qkv[:, :, 1], pos)
    v = qkv[:, :, 2]
    outs, lses = [], []
    for g, (window, dil) in enumerate(DIL_GROUPS):
        sl = slice(g * DIL_HEADS, (g + 1) * DIL_HEADS)
        o, lse = dilated_window_attention(q[:, :, sl], k[:, :, sl], v[:, :, sl], window, dil)
        outs.append(o)
        lses.append(lse)
    alpha = jax.nn.softmax(jnp.stack(lses, axis=0), axis=0)
    o = jnp.sum(alpha[..., None] * jnp.stack(outs, axis=0), axis=0)
    y = o.reshape(B, S, DIL_WIDTH).astype(h.dtype) * jax.nn.silu(gate)
    return y @ w_out


def diff_mixer(h, w_in, lq1, lk1, lq2, lk2, subln, w_out, lambda_init):
    B, S, _ = h.shape
    pos = jnp.arange(S)
    proj = h @ w_in
    q = proj[..., :DIFF_QK_WIDTH].reshape(B, S, 2 * DIFF_HEADS, DIFF_QK_DIM)
    k = proj[..., DIFF_QK_WIDTH:2 * DIFF_QK_WIDTH].reshape(B, S, 2 * DIFF_HEADS, DIFF_QK_DIM)
    v = proj[..., 2 * DIFF_QK_WIDTH:2 * DIFF_QK_WIDTH + DIFF_WIDTH].reshape(B, S, DIFF_HEADS, DIFF_V_DIM)
    gate = proj[..., 2 * DIFF_QK_WIDTH + DIFF_WIDTH:]
    q = rope(q, pos).reshape(B, S, DIFF_HEADS, 2, DIFF_QK_DIM)
    k = rope(k, pos).reshape(B, S, DIFF_HEADS, 2, DIFF_QK_DIM)
    lam = (jnp.exp(jnp.sum(lq1.astype(jnp.float32) * lk1.astype(jnp.float32)))
           - jnp.exp(jnp.sum(lq2.astype(jnp.float32) * lk2.astype(jnp.float32))) + lambda_init)
    n_qb = S // Q_BLOCK
    qb = q.reshape(B, n_qb, Q_BLOCK, DIFF_HEADS, 2, DIFF_QK_DIM).transpose(1, 0, 2, 3, 4, 5)
    scale = DIFF_QK_DIM ** -0.5
    kpos = jnp.arange(S)

    def block(args):
        qblk, bi = args
        s = jnp.einsum('bqhcd,bkhcd->bchqk', qblk, k).astype(jnp.float32) * scale
        qpos = bi * Q_BLOCK + jnp.arange(Q_BLOCK)
        s = jnp.where(kpos[None, :] <= qpos[:, None], s, -jnp.inf)
        p = jax.nn.softmax(s, axis=-1)
        a = p[:, 0] - lam * p[:, 1]
        return jnp.einsum('bhqk,bkhd->bqhd', a.astype(v.dtype), v)

    o = lax.map(block, (qb, jnp.arange(n_qb)))
    o = o.transpose(1, 0, 2, 3, 4).reshape(B, S, DIFF_HEADS, DIFF_V_DIM)
    o = rmsnorm(o, subln) * (1.0 - lambda_init)
    y = o.reshape(B, S, DIFF_WIDTH) * jax.nn.silu(gate)
    return y @ w_out


def setup_inputs(seed: int = 0) -> dict:
    key = jax.random.key(seed)
    ks = jax.random.split(key, 12)
    f32 = jnp.float32
    x = jax.random.normal(ks[0], (BATCH, SEQ, D_MODEL), f32)
    norm_pre = 1.0 + 0.05 * jax.random.normal(ks[1], (DEPTH, D_MODEL), f32)
    norm_post = 1.0 + 0.05 * jax.random.normal(ks[2], (DEPTH, D_MODEL), f32)
    dil_w_in = jax.random.normal(ks[3], (N_DIL_LAYERS, D_MODEL, DIL_IN), f32) * D_MODEL ** -0.5
    dil_w_out = jax.random.normal(ks[4], (N_DIL_LAYERS, DIL_WIDTH, D_MODEL), f32) * DIL_WIDTH ** -0.5
    diff_w_in = jax.random.normal(ks[5], (N_DIFF_LAYERS, D_MODEL, DIFF_IN), f32) * D_MODEL ** -0.5
    diff_w_out = jax.random.normal(ks[6], (N_DIFF_LAYERS, DIFF_WIDTH, D_MODEL), f32) * DIFF_WIDTH ** -0.5
    diff_lambda_q1 = 0.1 * jax.random.normal(ks[7], (N_DIFF_LAYERS, DIFF_QK_DIM), f32)
    diff_lambda_k1 = 0.1 * jax.random.normal(ks[8], (N_DIFF_LAYERS, DIFF_QK_DIM), f32)
    diff_lambda_q2 = 0.1 * jax.random.normal(ks[9], (N_DIFF_LAYERS, DIFF_QK_DIM), f32)
    diff_lambda_k2 = 0.1 * jax.random.normal(ks[10], (N_DIFF_LAYERS, DIFF_QK_DIM), f32)
    diff_subln = 1.0 + 0.05 * jax.random.normal(ks[11], (N_DIFF_LAYERS, DIFF_V_DIM), f32)
    return {"x": x, "norm_pre": norm_pre, "norm_post": norm_post,
            "dil_w_in": dil_w_in, "dil_w_out": dil_w_out,
            "diff_w_in": diff_w_in, "diff_w_out": diff_w_out,
            "diff_lambda_q1": diff_lambda_q1, "diff_lambda_k1": diff_lambda_k1,
            "diff_lambda_q2": diff_lambda_q2, "diff_lambda_k2": diff_lambda_k2,
            "diff_subln": diff_subln}


def reference(x, norm_pre, norm_post, dil_w_in, dil_w_out, diff_w_in, diff_w_out,
              diff_lambda_q1, diff_lambda_k1, diff_lambda_q2, diff_lambda_k2, diff_subln):
    h = x
    for i in range(DEPTH):
        u = rmsnorm(h, norm_pre[i])
        j = i // N_MIXERS
        if i % N_MIXERS == 0:
            y = dilated_mixer(u, dil_w_in[j], dil_w_out[j])
        else:
            lambda_init = 0.8 - 0.6 * math.exp(-0.3 * i)
            y = diff_mixer(u, diff_w_in[j], diff_lambda_q1[j], diff_lambda_k1[j],
                           diff_lambda_q2[j], diff_lambda_k2[j], diff_subln[j],
                           diff_w_out[j], lambda_init)
        h = h + rmsnorm(y, norm_post[i])
    return h
```

```cpp
#include <hip/hip_runtime.h>
#include <cstdio>
#include <cstdint>
#include <cmath>

namespace nv {
constexpr int S = 4096, D = 1024, NB = 8, M = NB * S;
constexpr int DIL_IN = 10240, DIFF_IN = 4096;
constexpr float EPS = 1e-6f;

__global__ void __launch_bounds__(256) k_rms(const float* __restrict__ x, const float* __restrict__ g, float* __restrict__ out, int rows) {
    const int wave = (blockIdx.x * 256 + threadIdx.x) >> 6, lane = threadIdx.x & 63;
    if (wave >= rows) return;
    const float* xr = x + (size_t)wave * D; float* o = out + (size_t)wave * D;
    float v[16]; float ss = 0.f;
#pragma unroll
    for (int j = 0; j < 16; ++j) { v[j] = xr[j * 64 + lane]; ss += v[j] * v[j]; }
#pragma unroll
    for (int off = 1; off < 64; off <<= 1) ss += __shfl_xor(ss, off);
    const float r = 1.0f / sqrtf(ss * (1.0f / D) + EPS);
#pragma unroll
    for (int j = 0; j < 16; ++j) o[j * 64 + lane] = v[j] * r * g[j * 64 + lane];
}
__global__ void __launch_bounds__(256) k_post(const float* __restrict__ base, const float* __restrict__ t, const float* __restrict__ g, float* __restrict__ out, int rows) {
    const int wave = (blockIdx.x * 256 + threadIdx.x) >> 6, lane = threadIdx.x & 63;
    if (wave >= rows) return;
    const float* tr = t + (size_t)wave * D; const float* br = base + (size_t)wave * D; float* o = out + (size_t)wave * D;
    float v[16]; float ss = 0.f;
#pragma unroll
    for (int j = 0; j < 16; ++j) { v[j] = tr[j * 64 + lane]; ss += v[j] * v[j]; }
#pragma unroll
    for (int off = 1; off < 64; off <<= 1) ss += __shfl_xor(ss, off);
    const float r = 1.0f / sqrtf(ss * (1.0f / D) + EPS);
#pragma unroll
    for (int j = 0; j < 16; ++j) o[j * 64 + lane] = br[j * 64 + lane] + v[j] * r * g[j * 64 + lane];
}
__global__ void __launch_bounds__(256) k_gemm(const float* __restrict__ A, const float* __restrict__ B, float* __restrict__ C, int K, int ldb, int ldc) {
    __shared__ float As[16][64 + 4];
    __shared__ float Bs[16][64 + 4];
    const int tid = threadIdx.x, tx = tid & 15, ty = tid >> 4;
    const int row0 = blockIdx.y * 64, col0 = blockIdx.x * 64;
    float acc[4][4];
#pragma unroll
    for (int i = 0; i < 4; ++i)
#pragma unroll
        for (int j = 0; j < 4; ++j) acc[i][j] = 0.f;
    for (int k0 = 0; k0 < K; k0 += 16) {
#pragma unroll
        for (int i = 0; i < 4; ++i) { const int e = tid + i * 256, r = e >> 4, kk = e & 15; As[kk][r] = A[(size_t)(row0 + r) * K + k0 + kk]; }
#pragma unroll
        for (int i = 0; i < 4; ++i) { const int e = tid + i * 256, kk = e >> 6, c = e & 63; Bs[kk][c] = B[(size_t)(k0 + kk) * ldb + col0 + c]; }
        __syncthreads();
#pragma unroll
        for (int kk = 0; kk < 16; ++kk) {
            float a[4], b[4];
#pragma unroll
            for (int i = 0; i < 4; ++i) a[i] = As[kk][ty * 4 + i];
#pragma unroll
            for (int j = 0; j < 4; ++j) b[j] = Bs[kk][tx * 4 + j];
#pragma unroll
            for (int i = 0; i < 4; ++i)
#pragma unroll
                for (int j = 0; j < 4; ++j) acc[i][j] = fmaf(a[i], b[j], acc[i][j]);
        }
        __syncthreads();
    }
#pragma unroll
    for (int i = 0; i < 4; ++i)
#pragma unroll
        for (int j = 0; j < 4; ++j) C[(size_t)(row0 + ty * 4 + i) * ldc + col0 + tx * 4 + j] = acc[i][j];
}
__global__ void __launch_bounds__(256) k_rope(float* __restrict__ P, int ld, int nheads, int rows) {
    const long idx = (long)blockIdx.x * 256 + threadIdx.x;
    const long total = (long)rows * nheads * 32;
    if (idx >= total) return;
    const int j = (int)(idx & 31); const long t = idx >> 5; const int head = (int)(t % nheads); const int row = (int)(t / nheads);
    const float freq = powf(10000.0f, -(float)(2 * j) / 64.0f);
    const float ang = (float)row * freq;
    const float c = cosf(ang), s = sinf(ang);
    float* p = P + (size_t)row * ld + head * 64;
    const float x1 = p[j], x2 = p[j + 32];
    p[j] = x1 * c - x2 * s; p[j + 32] = x2 * c + x1 * s;
}
__global__ void __launch_bounds__(64) k_dil(const float* __restrict__ P, float* __restrict__ Y) {
    const int idx = blockIdx.x * 64 + threadIdx.x;
    const int h = idx / S, s = idx % S;
    float o[64]; float m = -INFINITY, l = 0.f;
#pragma unroll
    for (int d = 0; d < 64; ++d) o[d] = 0.f;
    for (int g = 0; g < 3; ++g) {
        const int dil = (g == 0) ? 1 : (g == 1 ? 4 : 16);
        const int head = g * 16 + h;
        float q[64];
        const float* qp = P + (size_t)s * DIL_IN + head * 64;
#pragma unroll
        for (int d = 0; d < 64; ++d) q[d] = qp[d];
        for (int j = 0; j <= 128; ++j) {
            const int kp = s - j * dil; if (kp < 0) break;
            const float* kr = P + (size_t)kp * DIL_IN + 3072 + head * 64;
            float sc = 0.f;
#pragma unroll
            for (int d = 0; d < 64; ++d) sc = fmaf(q[d], kr[d], sc);
            sc *= 0.125f;
            const float mn = fmaxf(m, sc), a = expf(m - mn), p = expf(sc - mn);
            const float* vr = P + (size_t)kp * DIL_IN + 6144 + head * 64;
            l = l * a + p;
#pragma unroll
            for (int d = 0; d < 64; ++d) o[d] = o[d] * a + p * vr[d];
            m = mn;
        }
    }
    const float rl = 1.0f / l;
    const float* gp = P + (size_t)s * DIL_IN + 9216 + h * 64;
    float* y = Y + (size_t)s * D + h * 64;
#pragma unroll
    for (int d = 0; d < 64; ++d) { const float gt = gp[d]; y[d] = o[d] * rl * (gt / (1.0f + expf(-gt))); }
}
__global__ void __launch_bounds__(64) k_diff(const float* __restrict__ P, float* __restrict__ OB) {
    const int idx = blockIdx.x * 64 + threadIdx.x;
    const int s = idx % S; const int t = idx / S; const int vh = t & 1, c = (t >> 1) & 1, h = t >> 2;
    float q[64], o[64]; float m = -INFINITY, l = 0.f;
    const float* qp = P + (size_t)s * DIFF_IN + (2 * h + c) * 64;
#pragma unroll
    for (int d = 0; d < 64; ++d) { q[d] = qp[d]; o[d] = 0.f; }
    for (int kp = 0; kp <= s; ++kp) {
        const float* kr = P + (size_t)kp * DIFF_IN + 1024 + (2 * h + c) * 64;
        float sc = 0.f;
#pragma unroll
        for (int d = 0; d < 64; ++d) sc = fmaf(q[d], kr[d], sc);
        sc *= 0.125f;
        const float mn = fmaxf(m, sc), a = expf(m - mn), p = expf(sc - mn);
        const float* vr = P + (size_t)kp * DIFF_IN + 2048 + h * 128 + vh * 64;
        l = l * a + p;
#pragma unroll
        for (int d = 0; d < 64; ++d) o[d] = o[d] * a + p * vr[d];
        m = mn;
    }
    const float rl = 1.0f / l;
    float* ob = OB + ((size_t)s * 16 + (h * 2 + c)) * 128 + vh * 64;
#pragma unroll
    for (int d = 0; d < 64; ++d) ob[d] = o[d] * rl;
}
__global__ void __launch_bounds__(256) k_diffc(const float* __restrict__ OB, const float* __restrict__ P, const float* __restrict__ lq1, const float* __restrict__ lk1,
                                                const float* __restrict__ lq2, const float* __restrict__ lk2, const float* __restrict__ subln, float lambda_init, float* __restrict__ Y) {
    const int wave = (blockIdx.x * 256 + threadIdx.x) >> 6, lane = threadIdx.x & 63;
    const int s = wave >> 3, h = wave & 7;
    float d1 = lq1[lane] * lk1[lane], d2 = lq2[lane] * lk2[lane];
#pragma unroll
    for (int off = 1; off < 64; off <<= 1) { d1 += __shfl_xor(d1, off); d2 += __shfl_xor(d2, off); }
    const float lam = expf(d1) - expf(d2) + lambda_init;
    const float* o0 = OB + ((size_t)s * 16 + h * 2) * 128; const float* o1 = o0 + 128;
    const float a0 = o0[lane] - lam * o1[lane], a1 = o0[lane + 64] - lam * o1[lane + 64];
    float ss = a0 * a0 + a1 * a1;
#pragma unroll
    for (int off = 1; off < 64; off <<= 1) ss += __shfl_xor(ss, off);
    const float r = 1.0f / sqrtf(ss * (1.0f / 128.0f) + EPS);
    const float* gp = P + (size_t)s * DIFF_IN + 3072 + h * 128;
    const float g0 = gp[lane], g1 = gp[lane + 64];
    float* y = Y + (size_t)s * D + h * 128;
    y[lane] = a0 * r * subln[lane] * (1.0f - lambda_init) * (g0 / (1.0f + expf(-g0)));
    y[lane + 64] = a1 * r * subln[lane + 64] * (1.0f - lambda_init) * (g1 / (1.0f + expf(-g1)));
}
}

extern "C" void kernel_launch(void* const* d_in, const int* in_sizes, int n_in, void* d_out, int out_size, void* d_ws, size_t ws_size, hipStream_t stream) {
    using namespace nv;
    const float* x = (const float*)d_in[0];
    const float* norm_pre = (const float*)d_in[1]; const float* norm_post = (const float*)d_in[2];
    const float* dil_w_in = (const float*)d_in[3]; const float* dil_w_out = (const float*)d_in[4];
    const float* diff_w_in = (const float*)d_in[5]; const float* diff_w_out = (const float*)d_in[6];
    const float* lq1 = (const float*)d_in[7]; const float* lk1 = (const float*)d_in[8]; const float* lq2 = (const float*)d_in[9]; const float* lk2 = (const float*)d_in[10];
    const float* subln = (const float*)d_in[11];
    float* out = (float*)d_out;
    float* ws = (float*)d_ws;
    float* u = ws;
    float* proj = u + (size_t)S * D;
    float* y = proj + (size_t)S * DIL_IN;
    float* t = y + (size_t)S * D;
    float* ob = t + (size_t)S * D;
    const float lambda_init = (float)(0.8 - 0.6 * exp(-0.3 * 1.0));
    for (int b = 0; b < NB; ++b) {
        const float* xb = x + (size_t)b * S * D; float* hb = out + (size_t)b * S * D;
        k_rms<<<S / 4, 256, 0, stream>>>(xb, norm_pre, u, S);
        k_gemm<<<dim3(DIL_IN / 64, S / 64), 256, 0, stream>>>(u, dil_w_in, proj, D, DIL_IN, DIL_IN);
        k_rope<<<(S * 96 * 32) / 256, 256, 0, stream>>>(proj, DIL_IN, 96, S);
        k_dil<<<(S * 16) / 64, 64, 0, stream>>>(proj, y);
        k_gemm<<<dim3(D / 64, S / 64), 256, 0, stream>>>(y, dil_w_out, t, D, D, D);
        k_post<<<S / 4, 256, 0, stream>>>(xb, t, norm_post, hb, S);
    }
    for (int b = 0; b < NB; ++b) {
        float* hb = out + (size_t)b * S * D;
        k_rms<<<S / 4, 256, 0, stream>>>(hb, norm_pre + D, u, S);
        k_gemm<<<dim3(DIFF_IN / 64, S / 64), 256, 0, stream>>>(u, diff_w_in, proj, D, DIFF_IN, DIFF_IN);
        k_rope<<<(S * 32 * 32) / 256, 256, 0, stream>>>(proj, DIFF_IN, 32, S);
        k_diff<<<(S * 32) / 64, 64, 0, stream>>>(proj, ob);
        k_diffc<<<(S * 8) / 4, 256, 0, stream>>>(ob, proj, lq1, lk1, lq2, lk2, subln, lambda_init, y);
        k_gemm<<<dim3(D / 64, S / 64), 256, 0, stream>>>(y, diff_w_out, t, D, D, D);
        k_post<<<S / 4, 256, 0, stream>>>(hb, t, norm_post + D, hb, S);
    }
}
```

```cpp
#include <hip/hip_runtime.h>
#include <hip/hip_cooperative_groups.h>
#include <hip/hip_bf16.h>
#include <cstdio>
#include <cstdint>
#include <cmath>
namespace cg = cooperative_groups;
__device__ __forceinline__ int lane_now() { int l = (int)__builtin_amdgcn_mbcnt_hi(~0u, __builtin_amdgcn_mbcnt_lo(~0u, 0u)); asm volatile("" : "+v"(l)); return l; }
#ifndef PROBE_EPI2
#define PROBE_EPI2 0
#endif
#ifndef DIAG_MODE
#define DIAG_MODE 0
#endif
#ifndef PROBE_KLOOP2
#define PROBE_KLOOP2 0
#endif
#ifndef PROBE_P5DUMMY
#define PROBE_P5DUMMY 0
#endif
namespace pg8 {
#define PG8_LAS __attribute__((address_space(3)))
typedef unsigned short bf16_t;
typedef short bf16x8 __attribute__((ext_vector_type(8)));
typedef float f32x4 __attribute__((ext_vector_type(4)));
typedef unsigned u32x4 __attribute__((ext_vector_type(4)));
constexpr int BM = 256, BK = 64, HALF = 128, HTB = HALF * BK * 2  , STAGE_BYTES = 8 * HTB, NXCD = 8, WGM = 8;

__host__ __device__ __forceinline__ int lds_byte(int r, int c) { const int st = (r >> 4) * 2 + (c >> 5), rr = r & 15, cc = c & 31, ob = rr * 64 + cc * 2; return st * 1024 + (ob ^ (((ob >> 9) & 1) << 5)); }
__host__ __device__ __forceinline__ void stage_rc(int b, int& R, int& C) { const int st = b / 1024, sb = b % 1024, swz = sb ^ (((sb >> 9) & 1) << 5); R = (st >> 1) * 16 + swz / 64; C = (st & 1) * 32 + (swz % 64) / 2; }
__host__ __device__ __forceinline__ int perm32(int rho) { const int n = rho >> 4, i = rho & 15; return 8 * (i >> 2) + 4 * n + (i & 3); }

struct Unit { int pm, pn; };
struct Gemm { const bf16_t* A; const bf16_t* Bt; int M, N, K; };

struct StaticOrder {
    int nM, nN, nwg, G, c, rep;
    __host__ __device__ void init(int M, int N, int G_, int c_, int rep_ = 1) { nM = M / BM; nN = N / BM; nwg = nM * nN; G = G_; c = c_; rep = rep_; }
    __host__ __device__ bool next(int i, Unit& u) const {
        if (rep > 1) { const int per = nwg / G; if (i >= per * rep) return false; i %= per; }
        const long L = (long)i * G + c; if (L >= nwg) return false;
        int wgid = (int)L; { const int q = nwg / NXCD, r = nwg % NXCD, xcd = wgid % NXCD, off = wgid / NXCD; wgid = (xcd < r ? xcd * (q + 1) : r * (q + 1) + (xcd - r) * q) + off; }
        const int nig = WGM * nN, gid = wgid / nig, fm = gid * WGM, gsz = (nM - fm) < WGM ? (nM - fm) : WGM;
        u.pm = fm + ((wgid % nig) % gsz); u.pn = (wgid % nig) / gsz; return true;
    }
    __device__ __forceinline__ void a_ready(const Unit&) const {}
    __device__ __forceinline__ void done(const Unit&) const {}
};


__device__ __forceinline__ unsigned cvt_pk_bf16(float lo, float hi) { typedef float f2 __attribute__((ext_vector_type(2))); typedef __bf16 b2 __attribute__((ext_vector_type(2))); f2 v = {lo, hi}; b2 b = __builtin_convertvector(v, b2); return __builtin_bit_cast(unsigned, b); }
typedef unsigned u32x2 __attribute__((ext_vector_type(2)));
struct EpiProj {
    static constexpr bool PERM = false, AFTER_DRAIN = false;
    bf16_t* base; size_t sec_stride; unsigned ropemask, scalemask, hmmask, lgd4, kimgmask; const float* cs; float qscale;
    template <bool ROPE, bool HM, bool KIMG>
    __device__ __forceinline__ void tile(const f32x4 (&acc)[2][2][4][2], const Unit& u, int wr, int wc, int fr, int fq, bf16_t* sb, float sc, int lgd) const {
        const int row0 = u.pm * BM + wr * 64 + fr; const int bidx = (u.pm * BM) >> 12;
        const int w1 = wc & 1, hsub = wc >> 1;
        float Fh[4], Fl[4];
        if (ROPE) {
#pragma unroll
            for (int i = 0; i < 4; ++i) { const float F = __builtin_amdgcn_exp2f(-(float)(w1 * 16 + 4 * fq + i) * (13.287712379549449f / 32.0f)) * 0.15915494309189535f;
                Fh[i] = __uint_as_float(__float_as_uint(F) & 0xfffff000u); Fl[i] = F - Fh[i]; }
        }
#pragma unroll
        for (int ai = 0; ai < 2; ++ai)
#pragma unroll
            for (int m = 0; m < 4; ++m) {
                const int row = row0 + ai * HALF + m * 16; const int s = row & 4095;
                const int rho = ((s & ((1 << lgd) - 1)) << (12 - lgd)) + (s >> lgd);
#pragma unroll
                for (int bj = 0; bj < 2; ++bj) {
                    const int head = (u.pn & 3) * 4 + bj * 2 + hsub;
                    bf16_t* hb = sb + (size_t)(bidx * 16 + head) * (4096 * 64);
                    bf16_t* rp = sb + (size_t)row * 1024 + head * 64;
                    const f32x4 a0 = acc[ai][bj][m][0], a1 = acc[ai][bj][m][1];
                    if (ROPE) {
                        f32x4 cvv, svv;
#pragma unroll
                        for (int i = 0; i < 4; ++i) { const float ps = (float)s; const float rev = __builtin_amdgcn_fractf(ps * Fh[i]) + ps * Fl[i]; cvv[i] = __builtin_amdgcn_cosf(rev); svv[i] = __builtin_amdgcn_sinf(rev); }
                        const f32x4 lo = (a0 * cvv - a1 * svv) * sc, hi = (a1 * cvv + a0 * svv) * sc;
                        u32x2 wl, wh; wl.x = cvt_pk_bf16(lo[0], lo[1]); wl.y = cvt_pk_bf16(lo[2], lo[3]); wh.x = cvt_pk_bf16(hi[0], hi[1]); wh.y = cvt_pk_bf16(hi[2], hi[3]);
                        const auto sx = __builtin_amdgcn_permlane16_swap(wl.x, wh.x, false, false); const auto sy = __builtin_amdgcn_permlane16_swap(wl.y, wh.y, false, false);
                        u32x4 w; w.x = sx[0]; w.y = sy[0]; w.z = sx[1]; w.w = sy[1];
                        const int d0 = (fq & 1) * 32 + w1 * 16 + (fq >> 1) * 8;
                        if (!HM) *(u32x4*)(rp + d0) = w;
                        else if (KIMG) *(u32x4*)(hb + (rho >> 6) * 4096 + (d0 >> 3) * 512 + (rho & 63) * 8) = w;
                        else *(u32x4*)(hb + (rho >> 5) * 2048 + (d0 >> 3) * 256 + (rho & 31) * 8) = w;
                    } else {
                        u32x4 w; w.x = cvt_pk_bf16(a0[0], a0[1]); w.y = cvt_pk_bf16(a0[2], a0[3]); w.z = cvt_pk_bf16(a1[0], a1[1]); w.w = cvt_pk_bf16(a1[2], a1[3]);
                        if (!HM) *(u32x4*)(rp + w1 * 32 + 8 * fq) = w;
                        else *(u32x4*)(hb + (rho >> 6) * 4096 + w1 * 2048 + (rho & 63) * 32 + 8 * fq) = w;
                    }
                }
            }
    }
    __device__ __forceinline__ void operator()(const f32x4 (&acc)[2][2][4][2], const Unit& u, int wr, int wc, int fr, int fq) const {
        const int sec = u.pn >> 2; const bool rope = (ropemask >> sec) & 1u, hm = (hmmask >> sec) & 1u; const float sc = ((scalemask >> sec) & 1u) ? qscale : 1.0f;
        const int lgd = (int)((lgd4 >> (4 * sec)) & 15u);
        bf16_t* sb = base + (size_t)sec * sec_stride;
        const bool kimg = (kimgmask >> sec) & 1u;
        if (rope) { if (hm) { if (kimg) tile<true, true, true>(acc, u, wr, wc, fr, fq, sb, sc, lgd); else tile<true, true, false>(acc, u, wr, wc, fr, fq, sb, sc, lgd); } else tile<true, false, false>(acc, u, wr, wc, fr, fq, sb, sc, lgd); }
        else      { if (hm) tile<false, true, false>(acc, u, wr, wc, fr, fq, sb, sc, lgd); else tile<false, false, false>(acc, u, wr, wc, fr, fq, sb, sc, lgd); }
    }
};
template <class Epi, class Sched, bool ALIGN_EPI = false, bool SP2 = false>
__device__ __forceinline__ void gemm_phase(PG8_LAS unsigned char* lds, const Gemm g, const Sched& S, const Epi& E) {
    int tid_ = threadIdx.x; asm volatile("" : "+v"(tid_)); __builtin_assume(tid_ >= 0 && tid_ < 512);
    const int tid = tid_, wid = __builtin_amdgcn_readfirstlane(tid >> 6), lane = tid & 63, wr = wid >> 2, wc = wid & 3, fr = lane & 15, fq = lane >> 4;
    const int K = g.K, nt = K / BK;
    unsigned voffA[2], voffB[2];
#pragma unroll
    for (int i = 0; i < 2; ++i) { int R, C; stage_rc(tid * 16 + i * 8192, R, C); const int Rb = Epi::PERM ? ((R & ~31) + perm32(R & 31)) : R;
        voffA[i] = (unsigned)(R * K + C) * 2u; voffB[i] = (unsigned)(Rb * K + C) * 2u; }
    const size_t kstep = (size_t)(BK * 2);
    const size_t hstep = (size_t)HALF * K * 2;
    const size_t tstep = 2 * hstep;
    const unsigned ldsw = (unsigned)wid * 1024u;
    const int aoff = lds_byte(wr * 64 + fr, fq * 8), boff = lds_byte(wc * 32 + fr, fq * 8);
#define PG8_SA(b, h) (((b) * 2 + (h)) * HTB)
#define PG8_SB(b, h) ((4 + (b) * 2 + (h)) * HTB)
#define PG8_STAGE(bufoff, gbase, voff) do { _Pragma("unroll") for (int _i = 0; _i < 2; ++_i) \
        __builtin_amdgcn_global_load_lds((const unsigned*)((const char*)(gbase) + (voff)[_i]), (PG8_LAS unsigned*)(lds + (bufoff) + ldsw + _i * 8192), 16, 0, 0); } while (0)
#define PG8_LDA(dst, b, h) do { _Pragma("unroll") for (int m = 0; m < 4; ++m) _Pragma("unroll") for (int k = 0; k < 2; ++k) dst[m][k] = *(const PG8_LAS bf16x8*)(lds + PG8_SA(b, h) + aoff + m * 2048 + k * 1024); } while (0)
#define PG8_LDB(dst, b, h) do { _Pragma("unroll") for (int n = 0; n < 2; ++n) _Pragma("unroll") for (int k = 0; k < 2; ++k) dst[n][k] = *(const PG8_LAS bf16x8*)(lds + PG8_SB(b, h) + boff + n * 2048 + k * 1024); } while (0)
#define PG8_MMA(ai, bj, At, Bt) do { __builtin_amdgcn_s_setprio(1); _Pragma("unroll") for (int m = 0; m < 4; ++m) _Pragma("unroll") for (int n = 0; n < 2; ++n) _Pragma("unroll") for (int k = 0; k < 2; ++k) \
        acc[ai][bj][m][n] = __builtin_amdgcn_mfma_f32_16x16x32_bf16(Bt[n][k], At[m][k], acc[ai][bj][m][n], 0, 0, 0); __builtin_amdgcn_s_setprio(0); } while (0)
#define PG8_WAIT_V(n) asm volatile("s_waitcnt vmcnt(" #n ")" ::: "memory")
#define PG8_WAIT_L(n) asm volatile("s_waitcnt lgkmcnt(" #n ")" ::: "memory")
#define PG8_BAR __builtin_amdgcn_s_barrier()
#define PG8_SCHED __builtin_amdgcn_sched_barrier(0)
    Unit cur, nxt; int ui = 0;
    if (!S.next(0, cur)) return;
    f32x4 acc[2][2][4][2];
#pragma unroll
    for (int a = 0; a < 2; ++a)
#pragma unroll
        for (int b = 0; b < 2; ++b)
#pragma unroll
            for (int m = 0; m < 4; ++m)
#pragma unroll
                for (int n = 0; n < 2; ++n) acc[a][b][m][n] = (f32x4){0.f, 0.f, 0.f, 0.f};
    bf16x8 At[4][2], B0[2][2], B1[2][2];
    const char* cA = (const char*)g.A + (size_t)cur.pm * tstep; const char* cB = (const char*)g.Bt + (size_t)cur.pn * tstep;
    S.a_ready(cur);
    if constexpr (SP2) {
        PG8_STAGE(PG8_SB(0, 0), cB, voffB); PG8_STAGE(PG8_SB(0, 1), cB + hstep, voffB); PG8_STAGE(PG8_SA(0, 0), cA, voffA); PG8_STAGE(PG8_SA(0, 1), cA + hstep, voffA);
        if (wr == 1) PG8_BAR;
        PG8_WAIT_V(2); PG8_BAR;
        PG8_STAGE(PG8_SB(1, 0), cB + kstep, voffB); PG8_STAGE(PG8_SA(1, 0), cA + kstep, voffA); PG8_STAGE(PG8_SB(1, 1), cB + hstep + kstep, voffB);
        PG8_WAIT_V(6); PG8_BAR;
    } else {
        PG8_STAGE(PG8_SB(0, 0), cB, voffB); PG8_STAGE(PG8_SA(0, 0), cA, voffA); PG8_STAGE(PG8_SB(0, 1), cB + hstep, voffB); PG8_STAGE(PG8_SA(0, 1), cA + hstep, voffA);
        if (wr == 1) PG8_BAR;
        PG8_WAIT_V(4); PG8_BAR;
        PG8_STAGE(PG8_SB(1, 0), cB + kstep, voffB); PG8_STAGE(PG8_SA(1, 0), cA + kstep, voffA); PG8_STAGE(PG8_SB(1, 1), cB + hstep + kstep, voffB);
        PG8_WAIT_V(6); PG8_BAR;
    }
    for (;;) {
        const bool has_next = S.next(ui + 1, nxt);
        const char* nA = has_next ? (const char*)g.A + (size_t)nxt.pm * tstep : cA; const char* nB = has_next ? (const char*)g.Bt + (size_t)nxt.pn * tstep : cB;
        for (int t = 0; t < nt * (1 + PROBE_KLOOP2); t += 2) {
            const bool last = (t == nt * (1 + PROBE_KLOOP2) - 2);
            const char* a1 = cA + (size_t)((t + 1) % nt) * kstep;
            const char* a2 = last ? nA : cA + (size_t)((t + 2) % nt) * kstep; const char* b2 = last ? nB : cB + (size_t)((t + 2) % nt) * kstep;
            const char* a3 = a2 + kstep; const char* b3 = b2 + kstep;
            if (last && has_next) S.a_ready(nxt);
            if constexpr (SP2) {
            PG8_LDB(B0, 0, 0); PG8_LDB(B1, 0, 1); PG8_SCHED; PG8_LDA(At, 0, 0); PG8_STAGE(PG8_SA(1, 1), a1 + hstep, voffA);
            PG8_WAIT_V(8); PG8_WAIT_L(0); PG8_BAR; PG8_MMA(0, 0, At, B0); PG8_MMA(0, 1, At, B1); PG8_BAR; PG8_SCHED;
            PG8_LDA(At, 0, 1); PG8_STAGE(PG8_SB(0, 0), b2, voffB); PG8_STAGE(PG8_SB(0, 1), b2 + hstep, voffB); PG8_STAGE(PG8_SA(0, 0), a2, voffA);
            PG8_WAIT_V(8); PG8_WAIT_L(0); PG8_BAR; PG8_MMA(1, 0, At, B0); PG8_MMA(1, 1, At, B1); PG8_BAR; PG8_SCHED;
            PG8_LDB(B0, 1, 0); PG8_LDB(B1, 1, 1); PG8_SCHED; PG8_LDA(At, 1, 0); PG8_STAGE(PG8_SA(0, 1), a2 + hstep, voffA);
            PG8_WAIT_V(8); PG8_WAIT_L(0); PG8_BAR; PG8_MMA(0, 0, At, B0); PG8_MMA(0, 1, At, B1); PG8_BAR; PG8_SCHED;
            PG8_LDA(At, 1, 1); PG8_STAGE(PG8_SB(1, 0), b3, voffB); PG8_STAGE(PG8_SB(1, 1), b3 + hstep, voffB); PG8_STAGE(PG8_SA(1, 0), a3, voffA);
            PG8_WAIT_V(8); PG8_WAIT_L(0); PG8_BAR; PG8_MMA(1, 0, At, B0); PG8_MMA(1, 1, At, B1); PG8_BAR; PG8_SCHED;
            } else {
            PG8_LDB(B0, 0, 0); PG8_SCHED; PG8_LDA(At, 0, 0); PG8_STAGE(PG8_SA(1, 1), a1 + hstep, voffA);
            PG8_WAIT_L(8); PG8_BAR; PG8_WAIT_L(0); PG8_MMA(0, 0, At, B0); PG8_BAR; PG8_SCHED;
            PG8_LDB(B1, 0, 1); PG8_STAGE(PG8_SB(0, 0), b2, voffB);
            PG8_BAR; PG8_WAIT_L(0); PG8_MMA(0, 1, At, B1); PG8_BAR;
            PG8_LDA(At, 0, 1); PG8_STAGE(PG8_SA(0, 0), a2, voffA);
            PG8_BAR; PG8_WAIT_L(0); PG8_MMA(1, 0, At, B0); PG8_BAR; PG8_SCHED;
            PG8_STAGE(PG8_SB(0, 1), b2 + hstep, voffB);
            PG8_WAIT_V(6); PG8_BAR; PG8_MMA(1, 1, At, B1); PG8_BAR;
            PG8_LDB(B0, 1, 0); PG8_SCHED; PG8_LDA(At, 1, 0); PG8_STAGE(PG8_SA(0, 1), a2 + hstep, voffA);
            PG8_WAIT_L(8); PG8_BAR; PG8_WAIT_L(0); PG8_MMA(0, 0, At, B0); PG8_BAR; PG8_SCHED;
            PG8_LDB(B1, 1, 1); PG8_STAGE(PG8_SB(1, 0), b3, voffB);
            PG8_BAR; PG8_WAIT_L(0); PG8_MMA(0, 1, At, B1); PG8_BAR;
            PG8_LDA(At, 1, 1); PG8_STAGE(PG8_SA(1, 0), a3, voffA);
            PG8_BAR; PG8_WAIT_L(0); PG8_MMA(1, 0, At, B0); PG8_BAR; PG8_SCHED;
            PG8_STAGE(PG8_SB(1, 1), b3 + hstep, voffB);
            PG8_WAIT_V(6); PG8_BAR; PG8_MMA(1, 1, At, B1); PG8_BAR;
            }
        }
        if constexpr (ALIGN_EPI) { if (wr == 0) PG8_BAR; }
#if PROBE_KLOOP2
        _Pragma("unroll") for (int a = 0; a < 2; ++a) _Pragma("unroll") for (int b = 0; b < 2; ++b) _Pragma("unroll") for (int m = 0; m < 4; ++m) _Pragma("unroll") for (int n = 0; n < 2; ++n) acc[a][b][m][n] *= 0.5f;
#endif
        if constexpr (!Epi::AFTER_DRAIN) { E(acc, cur, wr, wc, fr, fq);
#if PROBE_EPI2
            asm volatile("" ::: "memory"); E(acc, cur, wr, wc, fr, fq);
#endif
            S.done(cur); }
        if (!has_next) break;
#pragma unroll
        for (int a = 0; a < 2; ++a)
#pragma unroll
            for (int b = 0; b < 2; ++b)
#pragma unroll
                for (int m = 0; m < 4; ++m)
#pragma unroll
                    for (int n = 0; n < 2; ++n) acc[a][b][m][n] = (f32x4){0.f, 0.f, 0.f, 0.f};
        cur = nxt; cA = nA; cB = nB; ++ui;
        if constexpr (ALIGN_EPI) { if (wr == 1) PG8_BAR; }
    }
    PG8_WAIT_V(0);
    if constexpr (!ALIGN_EPI) { if (wr == 0) PG8_BAR; }
    PG8_BAR;
    if constexpr (Epi::AFTER_DRAIN) { E.fused(acc, cur, wr, wc, fr, fq, lds, wid, lane); S.done(cur); }
#undef PG8_SA
#undef PG8_SB
#undef PG8_STAGE
#undef PG8_LDA
#undef PG8_LDB
#undef PG8_MMA
#undef PG8_WAIT_V
#undef PG8_WAIT_L
#undef PG8_BAR
#undef PG8_SCHED
}
}
namespace attn_body {
using bf16=__hip_bfloat16;
using bf16x8=__attribute__((ext_vector_type(8)))short;
using s16x4=__attribute__((ext_vector_type(4)))short;
using f32x16=__attribute__((ext_vector_type(16)))float;
using u32x4=__attribute__((ext_vector_type(4)))unsigned;
constexpr int BATCH=8,NHEAD=16,SEQ=4096,D=64,DM=NHEAD*D;
constexpr int NW=8,QBLK=32,QB=QBLK*NW,KVBLK=64,NQB=SEQ/QB;
constexpr int ATTN_PITCH=DM, ATTN_UNIT_ROWS=QB;
__device__ __forceinline__ int crow(int r,int hi){return (r&3)+8*(r>>2)+4*hi;}
#define SBAR() __builtin_amdgcn_sched_barrier(0)
__device__ __forceinline__ void cmask(f32x16&p0,f32x16&p1,int jb,int qrel,int hi){
  const float NEG=-INFINITY; int kb=64*jb+4*hi;
  #pragma unroll
  for(int r=0;r<16;++r){int kv=kb+(r&3)+8*(r>>2); if(kv>qrel)p0[r]=NEG; if(kv+32>qrel)p1[r]=NEG;}
}

constexpr int NSLOT=3, SLOTB=8192;
constexpr int LDS_K=0, LDS_V=NSLOT*SLOTB, LDS_WS=LDS_V+NSLOT*2*SLOTB, LDS_X=LDS_WS+NW*64*4  , LDS_BYTES=LDS_X+NW*8192, LDS_OST=0  ;
constexpr float C2=0.125f*1.4426950408889634f;
__device__ __forceinline__ void glds16(const void*gsrc,unsigned lds_dst){unsigned keep;
  asm volatile("s_mov_b32 %0, m0\n\ts_mov_b32 m0, %2\n\ts_nop 0\n\tglobal_load_lds_dwordx4 %1, off\n\ts_mov_b32 m0, %0":"=&s"(keep):"v"(gsrc),"s"(lds_dst):"memory");}
__device__ __forceinline__ float max3f(float a,float b,float c){float r;asm("v_max3_f32 %0, %1, %2, %3":"=v"(r):"v"(a),"v"(b),"v"(c));return r;}
__device__ __forceinline__ float max2f(float a,float b){float r;asm("v_max_f32_e32 %0, %1, %2":"=v"(r):"v"(a),"v"(b));return r;}
__device__ __forceinline__ float fadd_s(float a,float b){float r;asm("v_add_f32_e32 %0, %1, %2":"=v"(r):"v"(a),"v"(b));return r;}
__device__ __forceinline__ float fsub_s(float a,float b){float r;asm("v_sub_f32_e32 %0, %1, %2":"=v"(r):"v"(a),"v"(b));return r;}
typedef float f32x2_t __attribute__((ext_vector_type(2))); typedef __bf16 bf16x2_t __attribute__((ext_vector_type(2)));
__device__ __forceinline__ unsigned cvtpk_s(float lo,float hi){f32x2_t v={lo,hi};bf16x2_t b=__builtin_convertvector(v,bf16x2_t);return __builtin_bit_cast(unsigned,b);}
#define WAIT_BAR(N) asm volatile("s_waitcnt vmcnt(" #N ") lgkmcnt(0)\n\ts_barrier":::"memory")

__device__ __forceinline__ void qkt(f32x16&p0,f32x16&p1,const char*Kslot,const bf16x8*qr,const f32x16&negm,int r32,int hi){
  const char*kb=Kslot+hi*1024+r32*16;
  #pragma unroll
  for(int d0=0;d0<4;++d0){
    const bf16x8 b0=*reinterpret_cast<const bf16x8*>(kb+d0*2048);
    const bf16x8 b1=*reinterpret_cast<const bf16x8*>(kb+d0*2048+512);
    if(d0==0){p0=__builtin_amdgcn_mfma_f32_32x32x16_bf16(b0,qr[0],negm,0,0,0);p1=__builtin_amdgcn_mfma_f32_32x32x16_bf16(b1,qr[0],negm,0,0,0);}
    else{p0=__builtin_amdgcn_mfma_f32_32x32x16_bf16(b0,qr[d0],p0,0,0,0);p1=__builtin_amdgcn_mfma_f32_32x32x16_bf16(b1,qr[d0],p1,0,0,0);}}
}
typedef __attribute__((address_space(3))) const char* lds_cptr;
typedef short v4i16_t __attribute__((ext_vector_type(4)));
__device__ __forceinline__ void kload8(bf16x8*kf,lds_cptr kp){
  kf[0]=*(const __attribute__((address_space(3))) bf16x8*)(kp);      kf[1]=*(const __attribute__((address_space(3))) bf16x8*)(kp+512);
  kf[2]=*(const __attribute__((address_space(3))) bf16x8*)(kp+2048); kf[3]=*(const __attribute__((address_space(3))) bf16x8*)(kp+2560);
  kf[4]=*(const __attribute__((address_space(3))) bf16x8*)(kp+4096); kf[5]=*(const __attribute__((address_space(3))) bf16x8*)(kp+4608);
  kf[6]=*(const __attribute__((address_space(3))) bf16x8*)(kp+6144); kf[7]=*(const __attribute__((address_space(3))) bf16x8*)(kp+6656);
}
__device__ __forceinline__ void kload2(bf16x8*kf,lds_cptr kp,int j){ kf[2*j]=*(const __attribute__((address_space(3))) bf16x8*)(kp+j*2048); kf[2*j+1]=*(const __attribute__((address_space(3))) bf16x8*)(kp+j*2048+512); }
__device__ __forceinline__ s16x4 vtr(lds_cptr p){ return __builtin_bit_cast(s16x4,__builtin_amdgcn_ds_read_tr16_b64_v4i16((__attribute__((address_space(3))) v4i16_t*)p)); }
__device__ __forceinline__ float rowmax(const f32x16&p0,const f32x16&p1){
  float a=max3f(p0[0],p0[1],p1[0]),b=max3f(p0[2],p0[3],p1[1]);a=max3f(a,p1[2],p1[3]);
  #pragma unroll
  for(int r=4;r<16;r+=4){a=max3f(a,p0[r],p0[r+1]);b=max3f(b,p0[r+2],p0[r+3]);a=max3f(a,p1[r],p1[r+1]);b=max3f(b,p1[r+2],p1[r+3]);}
  const float m=max2f(a,b);
  auto rr=__builtin_amdgcn_permlane32_swap(__float_as_uint(m),__float_as_uint(m),false,false);
  return max2f(__uint_as_float(rr[0]),__uint_as_float(rr[1]));
}
__device__ __forceinline__ void pv(f32x16*o,int vb,bf16x8 pa0,bf16x8 pa1,bf16x8 pa2,bf16x8 pa3){
  #pragma unroll
  for(int d0=0;d0<4;++d0){s16x4 lo[4],hi[4];
    #pragma unroll
    for(int ks=0;ks<4;++ks){
      asm volatile("ds_read_b64_tr_b16 %0,%1 offset:%c2":"=&v"(lo[ks]):"v"(vb),"i"(d0*4096+ks*1024):"memory");
      asm volatile("ds_read_b64_tr_b16 %0,%1 offset:%c2":"=&v"(hi[ks]):"v"(vb),"i"(d0*4096+ks*1024+512):"memory");}
    asm volatile("s_waitcnt lgkmcnt(0)":::"memory");SBAR();
    #define PK(k) (bf16x8){lo[k][0],lo[k][1],lo[k][2],lo[k][3],hi[k][0],hi[k][1],hi[k][2],hi[k][3]}
    o[d0]=__builtin_amdgcn_mfma_f32_32x32x16_bf16(pa0,PK(0),o[d0],0,0,0);
    o[d0]=__builtin_amdgcn_mfma_f32_32x32x16_bf16(pa1,PK(1),o[d0],0,0,0);
    o[d0]=__builtin_amdgcn_mfma_f32_32x32x16_bf16(pa2,PK(2),o[d0],0,0,0);
    o[d0]=__builtin_amdgcn_mfma_f32_32x32x16_bf16(pa3,PK(3),o[d0],0,0,0);
    #undef PK
  }
}

#ifndef ATTN_STORE16
#define ATTN_STORE16(p,v) (*(u32x4*)(p)=(v))
#endif
typedef volatile __attribute__((address_space(3))) unsigned long long* diff_rec_t;
struct DiffEpi {
  static __device__ __forceinline__ void run(diff_rec_t rec,int pass,float*stg,unsigned*xs,const f32x16(&o)[4],const float*wsf,int row0,int lane,int r32,int hi){
    typedef float f32x4 __attribute__((ext_vector_type(4)));
    const float* subln=(const float*)rec[1]; const bf16* gate=(const bf16*)rec[2]; bf16* Yo=(bf16*)rec[3];
    const unsigned long long lw=rec[4]; const float lam=__uint_as_float((unsigned)lw), li1=__uint_as_float((unsigned)(lw>>32));
    float rli[16];
    #pragma unroll
    for(int r=0;r<16;++r)rli[r]=__builtin_amdgcn_rcpf(wsf[32+crow(r,hi)]);
    f32x4 da[4][2],db[4][2]; float ss[2]={0.f,0.f};
    #pragma unroll
    for(int g=0;g<4;++g){
      #pragma unroll
      for(int r=0;r<16;++r)stg[crow(r,hi)*32+r32]=o[g][r]*rli[r];
      asm volatile("s_waitcnt lgkmcnt(0)":::"memory");
      #pragma unroll
      for(int i=0;i<2;++i){ const int row=i*16+(lane>>2),ch=lane&3; const f32x4 va=*(const f32x4*)(stg+row*32+ch*8),vb=*(const f32x4*)(stg+row*32+ch*8+4);
        unsigned* xp=xs+((2*g+i)*64+lane)*4;
        if(pass==0){ u32x4 w; w[0]=cvtpk_s(va[0],va[1]); w[1]=cvtpk_s(va[2],va[3]); w[2]=cvtpk_s(vb[0],vb[1]); w[3]=cvtpk_s(vb[2],vb[3]); *(u32x4*)xp=w; }
        else if(pass==1){ const u32x4 w=*(const u32x4*)xp; f32x4 xa,xb; xa[0]=__uint_as_float(w[0]<<16); xa[1]=__uint_as_float(w[0]&0xffff0000u); xa[2]=__uint_as_float(w[1]<<16); xa[3]=__uint_as_float(w[1]&0xffff0000u);
          xb[0]=__uint_as_float(w[2]<<16); xb[1]=__uint_as_float(w[2]&0xffff0000u); xb[2]=__uint_as_float(w[3]<<16); xb[3]=__uint_as_float(w[3]&0xffff0000u);
          da[g][i]=xa-lam*va; db[g][i]=xb-lam*vb;
          #pragma unroll
          for(int k=0;k<4;++k) ss[i]+=da[g][i][k]*da[g][i][k]+db[g][i][k]*db[g][i][k]; }
      }
      asm volatile("s_waitcnt lgkmcnt(0)":::"memory");
    }
    if(pass==1){
      #pragma unroll
      for(int i=0;i<2;++i){ ss[i]+=__builtin_bit_cast(float,__builtin_amdgcn_update_dpp(0,__builtin_bit_cast(int,ss[i]),0xB1,0xF,0xF,true));
        ss[i]+=__builtin_bit_cast(float,__builtin_amdgcn_update_dpp(0,__builtin_bit_cast(int,ss[i]),0x4E,0xF,0xF,true));
        ss[i]=li1/sqrtf(ss[i]*(1.0f/128.0f)+1e-6f); }
      #pragma unroll
      for(int g=0;g<4;++g)
        #pragma unroll
        for(int i=0;i<2;++i){ const int row=i*16+(lane>>2),ch=lane&3; const long ro=(long)(row0+row)*DM+g*32+ch*8;
          const u32x4 gv=*(const u32x4*)(gate+ro); const f32x4 sa=*(const f32x4*)(subln+g*32+ch*8),sb=*(const f32x4*)(subln+g*32+ch*8+4);
          float y[8];
          #pragma unroll
          for(int k=0;k<4;++k){ y[k]=da[g][i][k]*ss[i]*sa[k]; y[4+k]=db[g][i][k]*ss[i]*sb[k]; }
          u32x4 w;
          #pragma unroll
          for(int k=0;k<4;++k){ const float ga=__uint_as_float(gv[k]<<16),gb=__uint_as_float(gv[k]&0xffff0000u);
            w[k]=cvtpk_s(y[2*k]*(ga/(1.0f+__expf(-ga))),y[2*k+1]*(gb/(1.0f+__expf(-gb)))); }
          *(u32x4*)(Yo+ro)=w; }
    }
  }
};
template<int THRL> __device__ __forceinline__ void attn_unit(int q0,const bf16*Qb,const bf16*__restrict__ Kh,const bf16*__restrict__ Vh,char*shm,int pass){
  int tid_=threadIdx.x; asm volatile("":"+v"(tid_));
  const int tid=tid_,lane=tid&63,r32=lane&31,hi=lane>>5; const int wid=__builtin_amdgcn_readfirstlane(tid>>6);
  const bf16*Qw=Qb+(long)(q0+wid*QBLK)*DM;
#if DIAG_MODE>=10 && DIAG_MODE<20
  const unsigned long long dg_in=__builtin_amdgcn_s_memtime();
#endif
  const unsigned lds0=(unsigned)(uintptr_t)shm;
  float*wsf=(float*)(shm+LDS_WS)+wid*64;
  const bf16*ksrc=Kh+(long)lane*DM+wid*8;
  const bf16*vsrc=Vh+(long)(16*(wid&3)+(lane>>2))*DM+(wid>>2)*32+(lane&3)*8;
  const unsigned kdst=lds0+LDS_K+wid*1024, vdst=lds0+LDS_V+wid*1024;
  #define DMA_K(t,slot) glds16(ksrc+(long)(t)*KVBLK*DM,(unsigned)__builtin_amdgcn_readfirstlane(kdst+(slot)))
  #define DMA_V(t,slot) do{ glds16(vsrc+(long)(t)*KVBLK*DM,(unsigned)__builtin_amdgcn_readfirstlane(vdst+2*(slot))); glds16(vsrc+(long)(t)*KVBLK*DM+64,(unsigned)__builtin_amdgcn_readfirstlane(vdst+2*(slot)+8192)); }while(0)
  const int vb0=(int)(lds0+LDS_V)+((lane>>4)&1)*32+(lane&3)*8+(4*hi+((lane&15)>>2))*64;
  const char*Kbase=shm+LDS_K; bf16x8 kf[8];
  const lds_cptr shm3=(lds_cptr)shm; const lds_cptr kp0=shm3+LDS_K+hi*1024+r32*16; const lds_cptr vp0=shm3+LDS_V+((lane>>4)&1)*32+(lane&3)*8+(4*hi+((lane&15)>>2))*64;
  const int NT=(q0+QB)/KVBLK;
  DMA_K(0,0);DMA_V(0,0);DMA_K(1,SLOTB);
  bf16x8 qr[4];
  #pragma unroll
  for(int d0=0;d0<4;++d0)qr[d0]=*reinterpret_cast<const bf16x8*>(&Qw[(long)r32*DM+d0*16+hi*8]);
  float mhat=0.f,l_reg=0.f;float z0_=0.f; asm volatile("":"+v"(z0_));     f32x16 o[4]; _Pragma("unroll") for(int d_=0;d_<4;++d_) _Pragma("unroll") for(int r=0;r<16;++r)o[d_][r]=z0_;f32x16 negm=f32x16{};asm volatile("":"+v"(negm));
  const int qrel=wid*QBLK+r32;
  #define CMASK(P0,P1,t) do{int jb_=(t)-(NT-4); if(jb_>=0)cmask(P0,P1,jb_,qrel,hi);}while(0)
  bool resc=false;
  #define START(P0,P1) do{ const float rm=rowmax(P0,P1); resc=false; \
    { const float dl=rm; mhat=fadd_s(mhat,dl); \
      _Pragma("unroll") for(int r=0;r<16;++r){P0[r]=fsub_s(P0[r],dl);P1[r]=fsub_s(P1[r],dl);} \
      _Pragma("unroll") for(int r=0;r<16;++r)negm[r]=-mhat; asm volatile("":"+v"(negm)); } \
    _Pragma("unroll") for(int r=0;r<16;++r)P0[r]=__builtin_amdgcn_exp2f(P0[r]); }while(0)
  #define RESC() do{ if(resc){ asm volatile("s_waitcnt lgkmcnt(0)":::"memory"); \
      _Pragma("unroll") for(int d_=0;d_<4;++d_) _Pragma("unroll") for(int r=0;r<16;++r)o[d_][r]*=wsf[crow(r,hi)]; } }while(0)
  f32x16 pA0,pA1,pB0,pB1;
  int sl_prev=0,sl_cur=0,sl_next=SLOTB;
  #define ROT() do{sl_prev=sl_cur;sl_cur=sl_next;sl_next=(sl_next==(NSLOT-1)*SLOTB)?0:sl_next+SLOTB;}while(0)
  DMA_K(2,2*SLOTB);
  WAIT_BAR(4);
  qkt(pA0,pA1,Kbase,qr,negm,r32,hi);asm volatile("s_nop 15\n\ts_nop 7":"+v"(pA0),"+v"(pA1));CMASK(pA0,pA1,0);
  START(pA0,pA1);
  _Pragma("unroll") for(int r=0;r<16;++r)pA1[r]=__builtin_amdgcn_exp2f(pA1[r]);
  WAIT_BAR(0);
  DMA_K(3,0);DMA_V(1,SLOTB);
  ROT();
  kload8(kf,kp0+sl_cur);
  WAIT_BAR(3);
  s16x4 vlo[16],vhi[16]; u32x4 pw0,pw1,pw2,pw3;
#if DIAG_MODE>=3 && DIAG_MODE<20
  unsigned long long dg_prev=__builtin_amdgcn_s_memtime(),dg_sum=0ull; unsigned dg_cnt=0u;
  #define DG_SEG(k) do{ SBAR(); const unsigned long long n_=__builtin_amdgcn_s_memtime(); if(DIAG_MODE==3+(k)) dg_sum+=n_-dg_prev; dg_prev=n_; SBAR(); }while(0)
  #define DG_CNT() do{ ++dg_cnt; }while(0)
#else
  #define DG_SEG(k) do{}while(0)
  #define DG_CNT() do{}while(0)
#endif
  #define PKW(P,B) cvtpk_s(P[B],P[B+1])
  #define PAF(k) __builtin_bit_cast(bf16x8,pw##k)
  #define VFR(i) (bf16x8){vlo[i][0],vlo[i][1],vlo[i][2],vlo[i][3],vhi[i][0],vhi[i][1],vhi[i][2],vhi[i][3]}
  #define PIN(x) asm volatile("":"+v"(x))
  #define MX3(a,b,c) __builtin_fmaxf(__builtin_fmaxf((a),(b)),(c))
  #define GAPA(MF,A0,A1,A2,A3,W0,W1,PW) do{ MF; sacc+=A0; sacc+=A1; sacc+=A2; sacc+=A3; PIN(sacc); W0; W1; PIN(PW); SBAR(); }while(0)
  #define EX(v) __builtin_amdgcn_exp2f(v)
  #define GAPM(MF,OPS) do{ MF; OPS; PIN(mxa_); PIN(mxb_); SBAR(); }while(0)
  #define EXI(X0,X1,e) do{ if((e)<16) X0[(e)&15]=EX(X0[(e)&15]); else X1[(e)&15]=EX(X1[(e)&15]); }while(0)
  #define GAPB3(MF,X0,X1,e0,e1,e2) do{ MF; EXI(X0,X1,e0); EXI(X0,X1,e1); EXI(X0,X1,e2); PIN(X0); PIN(X1); SBAR(); }while(0)
  #define GAPB2(MF,X0,X1,e0,e1) do{ MF; EXI(X0,X1,e0); EXI(X0,X1,e1); PIN(X0); PIN(X1); SBAR(); }while(0)
  #define VRD(j) do{ vlo[j]=vtr(vp_+(((j)&3)*4096+((j)>>2)*1024)); vhi[j]=vtr(vp_+(((j)&3)*4096+((j)>>2)*1024+512)); SBAR(); }while(0)
  #define PVM(j,k) o[(j)&3]=__builtin_amdgcn_mfma_f32_32x32x16_bf16(PAF(k),VFR(j),o[(j)&3],0,0,0)
  #define KRD(G,j) do{ if(G){ kload2(kf,kp0+sl_next,j); SBAR(); } }while(0)
  #define STEP(C0,C1,P0,P1,t,GK,GV,GL) do{ SBAR(); DG_SEG(3); DG_CNT(); \
    const lds_cptr vp_=vp0+2*sl_prev; \
    float sacc=(P0[0]+P0[1]); \
    GAPA(C0=__builtin_amdgcn_mfma_f32_32x32x16_bf16(kf[0],qr[0],negm,0,0,0), P0[2],P0[3],P0[4],P0[5],     pw0[0]=PKW(P0,0), pw0[1]=PKW(P0,2), pw0); \
    GAPA(C1=__builtin_amdgcn_mfma_f32_32x32x16_bf16(kf[1],qr[0],negm,0,0,0), P0[6],P0[7],P0[8],P0[9],     pw0[2]=PKW(P0,4), pw0[3]=PKW(P0,6), pw0); \
    GAPA(C0=__builtin_amdgcn_mfma_f32_32x32x16_bf16(kf[2],qr[1],C0,0,0,0),   P0[10],P0[11],P0[12],P0[13], pw1[0]=PKW(P0,8), pw1[1]=PKW(P0,10), pw1); \
    GAPA(C1=__builtin_amdgcn_mfma_f32_32x32x16_bf16(kf[3],qr[1],C1,0,0,0),   P0[14],P0[15],P1[0],P1[1],   pw1[2]=PKW(P0,12),pw1[3]=PKW(P0,14), pw1); \
    VRD(0); GAPA(C0=__builtin_amdgcn_mfma_f32_32x32x16_bf16(kf[4],qr[2],C0,0,0,0),   P1[2],P1[3],P1[4],P1[5],     pw2[0]=PKW(P1,0), pw2[1]=PKW(P1,2), pw2); \
    VRD(1); GAPA(C1=__builtin_amdgcn_mfma_f32_32x32x16_bf16(kf[5],qr[2],C1,0,0,0),   P1[6],P1[7],P1[8],P1[9],     pw2[2]=PKW(P1,4), pw2[3]=PKW(P1,6), pw2); \
    VRD(2); GAPA(C0=__builtin_amdgcn_mfma_f32_32x32x16_bf16(kf[6],qr[3],C0,0,0,0),   P1[10],P1[11],P1[12],P1[13], pw3[0]=PKW(P1,8), pw3[1]=PKW(P1,10), pw3); \
    VRD(3); GAPA(C1=__builtin_amdgcn_mfma_f32_32x32x16_bf16(kf[7],qr[3],C1,0,0,0),   P1[14],P1[15],0.f,0.f,       pw3[2]=PKW(P1,12),pw3[3]=PKW(P1,14), pw3); \
    l_reg+=sacc; DG_SEG(0); \
    if(GK){DMA_K((t)+3,sl_cur);} if(GV){DMA_V((t)+1,sl_next);} \
    CMASK(C0,C1,t); \
      \
    float mxa_,mxb_; \
    VRD(4);  GAPM(PVM(0,0), mxa_=MX3(C0[0],C0[1],C1[0]); mxb_=MX3(C0[2],C0[3],C1[1]); mxa_=MX3(mxa_,C1[2],C1[3]); mxa_=MX3(mxa_,C0[4],C0[5]); mxb_=MX3(mxb_,C0[6],C0[7])); \
    VRD(5);  GAPM(PVM(1,0), mxa_=MX3(mxa_,C1[4],C1[5]); mxb_=MX3(mxb_,C1[6],C1[7]); mxa_=MX3(mxa_,C0[8],C0[9]); mxb_=MX3(mxb_,C0[10],C0[11])); \
    VRD(6);  GAPM(PVM(2,0), mxa_=MX3(mxa_,C1[8],C1[9]); mxb_=MX3(mxb_,C1[10],C1[11]); mxa_=MX3(mxa_,C0[12],C0[13]); mxb_=MX3(mxb_,C0[14],C0[15])); \
    VRD(7);  GAPM(PVM(3,0), mxa_=MX3(mxa_,C1[12],C1[13]); mxb_=MX3(mxb_,C1[14],C1[15])); \
    { float rm=__builtin_fmaxf(mxa_,mxb_); { auto rr=__builtin_amdgcn_permlane32_swap(__float_as_uint(rm),__float_as_uint(rm),false,false); rm=__builtin_fmaxf(__uint_as_float(rr[0]),__uint_as_float(rr[1])); } \
      resc=false; \
      if(__builtin_expect(__any(rm>(float)THRL),0)){ const float dl=__builtin_fmaxf(rm,0.f); mhat+=dl; \
        _Pragma("unroll") for(int r=0;r<16;++r){C0[r]-=dl;C1[r]-=dl;} \
        _Pragma("unroll") for(int r=0;r<16;++r)negm[r]=-mhat; asm volatile("":"+v"(negm)); \
        const float f=__builtin_amdgcn_exp2f(-dl); l_reg*=f; if(hi==0)wsf[r32]=f; resc=true; } } \
    SBAR(); DG_SEG(1); \
    VRD(8);  GAPB3(PVM(4,1),C0,C1,0,1,2); \
    VRD(9);  KRD(GL,0); GAPB3(PVM(5,1),C0,C1,3,4,5); \
    VRD(10); GAPB3(PVM(6,1),C0,C1,6,7,8); \
    VRD(11); KRD(GL,1); GAPB3(PVM(7,1),C0,C1,9,10,11); \
    VRD(12); GAPB3(PVM(8,2),C0,C1,12,13,14); \
    VRD(13); KRD(GL,2); GAPB3(PVM(9,2),C0,C1,15,16,17); \
    VRD(14); GAPB3(PVM(10,2),C0,C1,18,19,20); \
    VRD(15); KRD(GL,3); GAPB3(PVM(11,2),C0,C1,21,22,23); \
    GAPB2(PVM(12,3),C0,C1,24,25); \
    GAPB2(PVM(13,3),C0,C1,26,27); \
    GAPB2(PVM(14,3),C0,C1,28,29); \
    GAPB2(PVM(15,3),C0,C1,30,31); DG_SEG(2); \
    }while(0)
#if DIAG_MODE==11
  const unsigned long long dg_p=__builtin_amdgcn_s_memtime()-dg_in;
#endif
  int t=1;
  #undef CMASK
  #define CMASK(P0,P1,t) do{}while(0)
  for(;t+5<NT;t+=2){
    STEP(pB0,pB1,pA0,pA1,t,true,true,true);     WAIT_BAR(3); RESC(); ROT();
    STEP(pA0,pA1,pB0,pB1,t+1,true,true,true);   WAIT_BAR(3); RESC(); ROT();
  }
  #undef CMASK
  #define CMASK(P0,P1,t) do{int jb_=(t)-(NT-4); if(jb_>=0)cmask(P0,P1,jb_,qrel,hi);}while(0)
  #define ENDW(tt) do{ if((tt)+3<NT){WAIT_BAR(3);} else if((tt)+2<NT){WAIT_BAR(2);} else {WAIT_BAR(0);} }while(0)
  for(;t+1<NT;t+=2){
    STEP(pB0,pB1,pA0,pA1,t,(t+3<NT),(t+1<NT),(t+1<NT));       ENDW(t);   RESC(); ROT();
    STEP(pA0,pA1,pB0,pB1,t+1,(t+4<NT),(t+2<NT),(t+2<NT));     ENDW(t+1); RESC(); ROT();
  }
  STEP(pB0,pB1,pA0,pA1,NT-1,false,false,false); RESC();
  { float sacc=pB0[0]+pB0[1]; _Pragma("unroll") for(int r=2;r<16;++r)sacc+=pB0[r]; _Pragma("unroll") for(int r=0;r<16;++r)sacc+=pB1[r]; l_reg+=sacc;
    pw0=(u32x4){PKW(pB0,0),PKW(pB0,2),PKW(pB0,4),PKW(pB0,6)};pw1=(u32x4){PKW(pB0,8),PKW(pB0,10),PKW(pB0,12),PKW(pB0,14)};pw2=(u32x4){PKW(pB1,0),PKW(pB1,2),PKW(pB1,4),PKW(pB1,6)};pw3=(u32x4){PKW(pB1,8),PKW(pB1,10),PKW(pB1,12),PKW(pB1,14)};
    SBAR(); pv(o,vb0+2*sl_cur,PAF(0),PAF(1),PAF(2),PAF(3)); }
  #undef PKW
  #undef PAF
  #undef VFR
  #undef PIN
  #undef MX3
  #undef GAPA
  #undef GAPB
  #undef EX
  #undef VRD
  #undef KRD
  #undef PVM
  #undef GAPM
  #undef EXI
  #undef GAPB3
  #undef GAPB2
  #undef STEP
  #undef ENDW
#if DIAG_MODE==8
  const unsigned long long dg_e0=__builtin_amdgcn_s_memtime();
#endif
#if DIAG_MODE>=3 && DIAG_MODE<8
  { diff_rec_t rc_=(diff_rec_t)((__attribute__((address_space(3))) char*)shm3+LDS_BYTES+wid*64); if(lane==0){ rc_[5]=rc_[5]+dg_sum; rc_[6]=rc_[6]+(unsigned long long)dg_cnt; } }
#endif
  {auto rr=__builtin_amdgcn_permlane32_swap(__float_as_uint(l_reg),__float_as_uint(l_reg),false,false);l_reg=__uint_as_float(rr[0])+__uint_as_float(rr[1]);}
  if(hi==0)wsf[32+r32]=l_reg;asm volatile("s_waitcnt lgkmcnt(0)\n\ts_barrier":::"memory");
  DiffEpi::run((diff_rec_t)((__attribute__((address_space(3))) char*)shm3+LDS_BYTES+wid*64),pass,(float*)(shm+LDS_OST)+wid*1024,(unsigned*)(shm+LDS_X)+wid*2048,o,wsf,q0+wid*QBLK,lane,r32,hi);
  asm volatile("s_waitcnt lgkmcnt(0)\n\ts_barrier":::"memory");
#if DIAG_MODE==8
  { diff_rec_t rc_=(diff_rec_t)((__attribute__((address_space(3))) char*)shm3+LDS_BYTES+wid*64); if(lane==0){ rc_[5]=rc_[5]+(__builtin_amdgcn_s_memtime()-dg_e0)/4ull; rc_[6]=rc_[6]+1ull; } }
#endif
#if DIAG_MODE==10
  { diff_rec_t rc_=(diff_rec_t)((__attribute__((address_space(3))) char*)shm3+LDS_BYTES+wid*64); if(lane==0){ rc_[5]=rc_[5]+(__builtin_amdgcn_s_memtime()-dg_in)/64ull; rc_[6]=rc_[6]+1ull; } }
#endif
#if DIAG_MODE==11
  { diff_rec_t rc_=(diff_rec_t)((__attribute__((address_space(3))) char*)shm3+LDS_BYTES+wid*64); if(lane==0){ rc_[5]=rc_[5]+dg_p/4ull; rc_[6]=rc_[6]+1ull; } }
#endif
  #undef DMA_K
  #undef DMA_V
  #undef CMASK
  #undef START
  #undef RESC
  #undef ROT
}
#undef SBAR
#undef WAIT_BAR
}

namespace win {
using attn_body::bf16; using attn_body::bf16x8; using attn_body::s16x4; using attn_body::f32x16; using attn_body::u32x4; using attn_body::lds_cptr;
using attn_body::glds16; using attn_body::vtr; using attn_body::cvtpk_s; using attn_body::crow;
constexpr int LK = 0, LV = 49152, LQ = 98304, LWS = 131072, LOST = 133120, WIN_LDS_BYTES = 149504;
struct Unit { int g, bh, rho0, first; };
#define WIN_WAITV(n) do { if ((n) == 4) asm volatile("s_waitcnt vmcnt(4)" ::: "memory"); else if ((n) == 6) asm volatile("s_waitcnt vmcnt(6)" ::: "memory"); else if ((n) == 8) asm volatile("s_waitcnt vmcnt(8)" ::: "memory"); \
    else if ((n) == 9) asm volatile("s_waitcnt vmcnt(9)" ::: "memory"); else if ((n) == 10) asm volatile("s_waitcnt vmcnt(10)" ::: "memory"); else if ((n) == 11) asm volatile("s_waitcnt vmcnt(11)" ::: "memory"); \
    else asm volatile("s_waitcnt vmcnt(0)" ::: "memory"); } while (0)
#define WIN_BAR() asm volatile("s_waitcnt lgkmcnt(0)\n\ts_barrier" ::: "memory")
template <bool COMBINE, class Dec>
__device__ __forceinline__ void phase(int ub, int ue, const Dec& dec, char* shm) {
    if (ub >= ue) return;
    constexpr int NST = COMBINE ? 4 : 5;
    int tid_ = threadIdx.x; asm volatile("" : "+v"(tid_));
    const int tid = tid_, lane = tid & 63, r32 = lane & 31, hi = lane >> 5; const int wid = __builtin_amdgcn_readfirstlane(tid >> 6);
    const unsigned lds0 = (unsigned)(uintptr_t)shm; const lds_cptr shm3 = (lds_cptr)shm;
    float* wsf = (float*)(shm + LWS) + wid * 64;
    const int koff = wid * 512 + lane * 8, voff = wid * 512 + lane * 8, qoff = wid * 2048 + lane * 8;
#define WIN_ISSUE_K(U) do { const bf16* ks_ = dec.K(U) + (long)((U).rho0 - 128) * 64 + koff; for (int t_ = (U).first ? 2 : 0; t_ < 6; ++t_) glds16(ks_ + (long)t_ * 4096, (unsigned)__builtin_amdgcn_readfirstlane(lds0 + LK + t_ * 8192 + wid * 1024)); } while (0)
#define WIN_ISSUE_V(U) do { const bf16* vs_ = dec.V(U) + (long)((U).rho0 - 128) * 64 + voff; for (int t_ = (U).first ? 2 : 0; t_ < 6; ++t_) glds16(vs_ + (long)t_ * 4096, (unsigned)__builtin_amdgcn_readfirstlane(lds0 + LV + t_ * 8192 + wid * 1024)); } while (0)
#define WIN_ISSUE_Q(U) do { const bf16* qs_ = dec.Q(U) + (long)(U).rho0 * 64 + qoff; _Pragma("unroll") for (int p_ = 0; p_ < 4; ++p_) glds16(qs_ + p_ * 512, (unsigned)__builtin_amdgcn_readfirstlane(lds0 + LQ + wid * 4096 + p_ * 1024)); } while (0)
#if DIAG_MODE>=30 && DIAG_MODE<40
    volatile unsigned long long* wgd = (volatile unsigned long long*)(shm + WIN_LDS_BYTES + wid * 32);
    if (!COMBINE && lane == 0) { wgd[0] = __builtin_amdgcn_s_memtime(); wgd[1] = 0ull; wgd[2] = 0ull; }
  #define WG_SEG(k) do{ __builtin_amdgcn_sched_barrier(0); if (!COMBINE && lane == 0) { const unsigned long long n_=__builtin_amdgcn_s_memtime(); if(DIAG_MODE==30+(k)) wgd[1]=wgd[1]+(n_-wgd[0]); wgd[0]=n_; } __builtin_amdgcn_sched_barrier(0); }while(0)
#else
  #define WG_SEG(k) do{}while(0)
#endif
    Unit cur = dec.unit(ub);
    WIN_ISSUE_K(cur); WIN_ISSUE_Q(cur); WIN_ISSUE_V(cur);
    for (int u = ub; u < ue; ++u) {
        const bool has_next = (u + 1 < ue);
        Unit nxt = cur; if (has_next) nxt = dec.unit(u + 1);
        const int np_cur = cur.first ? 4 : 6, np_nxt = has_next ? (nxt.first ? 4 : 6) : 0;
        WG_SEG(5);
        WIN_WAITV(u == ub ? np_cur : np_cur + NST); WIN_BAR();
        WG_SEG(0);
        bf16x8 qr[4];
        { const lds_cptr qb = shm3 + LQ + wid * 4096 + hi * 512 + r32 * 16;
#pragma unroll
          for (int d0 = 0; d0 < 4; ++d0) qr[d0] = *(const __attribute__((address_space(3))) bf16x8*)(qb + d0 * 1024); }
        f32x16 S[5];
        const int jlo = cur.first ? (4 - wid > 0 ? 4 - wid : 0) : 0;
#define WIN_KLD(dst, j_) do { const int bk_ = wid + (j_); const lds_cptr kb_ = shm3 + LK + (bk_ >> 1) * 8192 + (bk_ & 1) * 512 + hi * 1024 + r32 * 16; \
        _Pragma("unroll") for (int d0 = 0; d0 < 4; ++d0) dst[d0] = *(const __attribute__((address_space(3))) bf16x8*)(kb_ + d0 * 2048); } while (0)
        bf16x8 kfa[4];
#pragma unroll
        for (int j = 0; j < 5; ++j) {
            if (j >= jlo) {
                WIN_KLD(kfa, j);
                f32x16 a = {};
#pragma unroll
                for (int d0 = 0; d0 < 4; ++d0) a = __builtin_amdgcn_mfma_f32_32x32x16_bf16(kfa[d0], qr[d0], a, 0, 0, 0);
                S[j] = a;
            } else {
#pragma unroll
                for (int r = 0; r < 16; ++r) S[j][r] = -INFINITY;
            }
        }
#undef WIN_KLD
        WIN_BAR();
        WG_SEG(1);
        u32x4 pv1[2][2], pv2[2][2], pgv[2][2]; float pl1[2], pl2[2];
        if (COMBINE) {
            const int rw0_ = cur.rho0 + wid * 32;
#pragma unroll
            for (int i = 0; i < 2; ++i) { const int s = rw0_ + i * 16 + (lane >> 2), ch = lane & 3; const int rho1 = ((s & 3) << 10) + (s >> 2), rho2 = ((s & 15) << 8) + (s >> 4);
                pl1[i] = dec.L1h(cur)[rho1]; pl2[i] = dec.L2h(cur)[rho2];
#pragma unroll
                for (int d0 = 0; d0 < 2; ++d0) {
                    pv1[d0][i] = *(const u32x4*)(dec.O1h(cur) + (long)rho1 * 64 + d0 * 32 + ch * 8); pv2[d0][i] = *(const u32x4*)(dec.O2h(cur) + (long)rho2 * 64 + d0 * 32 + ch * 8);
                    pgv[d0][i] = *(const u32x4*)(dec.gate(cur) + (long)s * 1024 + d0 * 32 + ch * 8); } }
        }
        if (has_next) { WIN_ISSUE_K(nxt); WIN_ISSUE_Q(nxt); }
#pragma unroll
        for (int r = 0; r < 16; ++r) { const int kk = crow(r, hi); if (kk < r32) S[0][r] = -INFINITY; if (kk > r32) S[4][r] = -INFINITY; }
        float mx = S[4][0];
#pragma unroll
        for (int j = 0; j < 5; ++j)
#pragma unroll
            for (int r = 0; r < 16; ++r) mx = fmaxf(mx, S[j][r]);
        mx = fmaxf(mx, __shfl_xor(mx, 32));
        float l = 0.f;
#pragma unroll
        for (int j = 0; j < 5; ++j)
#pragma unroll
            for (int r = 0; r < 16; ++r) { const float p = __builtin_amdgcn_exp2f(S[j][r] - mx); S[j][r] = p; l += p; }
        l += __shfl_xor(l, 32);
        WG_SEG(2);
        WIN_WAITV(has_next ? np_nxt + 4 : 0); WIN_BAR();
        WG_SEG(3);
        f32x16 o[2]; o[0] = f32x16{}; o[1] = f32x16{};
        const unsigned vb0 = (unsigned)(uintptr_t)shm + LV + ((lane >> 4) & 1) * 32 + (lane & 3) * 8 + (4 * hi + ((lane & 15) >> 2)) * 64;
#pragma unroll
        for (int j = 0; j < 5; ++j) {
            if (j >= jlo) {
                const int bk = wid + j; const unsigned vt = vb0 + (bk >> 1) * 8192 + (bk & 1) * 2048;
                s16x4 vl[4], vh[4];
#pragma unroll
                for (int q = 0; q < 4; ++q) {
                    asm volatile("ds_read_b64_tr_b16 %0,%1 offset:%c2" : "=&v"(vl[q]) : "v"(vt), "i"((q & 1) * 4096 + (q >> 1) * 1024) : "memory");
                    asm volatile("ds_read_b64_tr_b16 %0,%1 offset:%c2" : "=&v"(vh[q]) : "v"(vt), "i"((q & 1) * 4096 + (q >> 1) * 1024 + 512) : "memory"); }
                u32x4 pw[2];
#pragma unroll
                for (int s2 = 0; s2 < 2; ++s2) { pw[s2][0] = cvtpk_s(S[j][8 * s2 + 0], S[j][8 * s2 + 1]); pw[s2][1] = cvtpk_s(S[j][8 * s2 + 2], S[j][8 * s2 + 3]); pw[s2][2] = cvtpk_s(S[j][8 * s2 + 4], S[j][8 * s2 + 5]); pw[s2][3] = cvtpk_s(S[j][8 * s2 + 6], S[j][8 * s2 + 7]); }
                asm volatile("s_waitcnt lgkmcnt(0)" : "+v"(vl[0]), "+v"(vl[1]), "+v"(vl[2]), "+v"(vl[3]), "+v"(vh[0]), "+v"(vh[1]), "+v"(vh[2]), "+v"(vh[3]) :: "memory"); __builtin_amdgcn_sched_barrier(0);
#pragma unroll
                for (int q = 0; q < 4; ++q) {
                    const bf16x8 vf = (bf16x8){vl[q][0], vl[q][1], vl[q][2], vl[q][3], vh[q][0], vh[q][1], vh[q][2], vh[q][3]};
                    o[q & 1] = __builtin_amdgcn_mfma_f32_32x32x16_bf16(__builtin_bit_cast(bf16x8, pw[q >> 1]), vf, o[q & 1], 0, 0, 0); }
            }
        }
        WIN_BAR();
        WG_SEG(4);
        if (COMBINE) {
#pragma unroll
            for (int d0 = 0; d0 < 2; ++d0)
#pragma unroll
                for (int i = 0; i < 2; ++i) asm volatile("" : "+v"(pv1[d0][i]), "+v"(pv2[d0][i]), "+v"(pgv[d0][i]));
            asm volatile("" : "+v"(pl1[0]), "+v"(pl1[1]), "+v"(pl2[0]), "+v"(pl2[1]));
        }
        if (has_next) WIN_ISSUE_V(nxt);
        if (hi == 0) { wsf[32 + r32] = l; wsf[r32] = mx + __builtin_amdgcn_logf(l); }
        asm volatile("s_waitcnt lgkmcnt(0)" ::: "memory");
        bf16* stg = (bf16*)(shm + LOST) + wid * 1024;
        const int rw0 = cur.rho0 + wid * 32;
#pragma unroll
        for (int d0 = 0; d0 < 2; ++d0) {
#pragma unroll
            for (int r = 0; r < 16; ++r) stg[crow(r, hi) * 32 + r32] = __float2bfloat16(o[d0][r] * __builtin_amdgcn_rcpf(wsf[32 + crow(r, hi)]));
            asm volatile("s_waitcnt lgkmcnt(0)" ::: "memory");
#pragma unroll
            for (int i = 0; i < 2; ++i) {
                const int row = i * 16 + (lane >> 2), ch = lane & 3; const u32x4 v0 = *(const u32x4*)(stg + row * 32 + ch * 8);
                if (!COMBINE) { *(u32x4*)(dec.Opart(cur) + (long)(rw0 + row) * 64 + d0 * 32 + ch * 8) = v0; }
                else {
                    const int s = rw0 + row;
                    const float l0 = wsf[row], l1 = pl1[i], l2 = pl2[i];
                    const u32x4 v1 = pv1[d0][i], v2 = pv2[d0][i], gv = pgv[d0][i];
                    const float mm = fmaxf(l0, fmaxf(l1, l2));
                    float e0 = __builtin_amdgcn_exp2f(l0 - mm), e1 = __builtin_amdgcn_exp2f(l1 - mm), e2 = __builtin_amdgcn_exp2f(l2 - mm);
                    const float inv = 1.0f / (e0 + e1 + e2); e0 *= inv; e1 *= inv; e2 *= inv;
                    u32x4 ov;
#pragma unroll
                    for (int k = 0; k < 4; ++k) {
                        float y[2];
#pragma unroll
                        for (int hh = 0; hh < 2; ++hh) {
                            const float a0 = __uint_as_float(hh ? (v0[k] & 0xffff0000u) : (v0[k] << 16)), a1 = __uint_as_float(hh ? (v1[k] & 0xffff0000u) : (v1[k] << 16)), a2 = __uint_as_float(hh ? (v2[k] & 0xffff0000u) : (v2[k] << 16));
                            const float g = __uint_as_float(hh ? (gv[k] & 0xffff0000u) : (gv[k] << 16));
                            const float oc = e0 * a0 + e1 * a1 + e2 * a2;
                            y[hh] = oc * (g / (1.0f + __expf(-g)));
                        }
                        ov[k] = cvtpk_s(y[0], y[1]);
                    }
                    *(u32x4*)(dec.Yp(cur) + (long)s * 1024 + d0 * 32 + ch * 8) = ov;
                }
            }
            asm volatile("s_waitcnt lgkmcnt(0)" ::: "memory");
        }
        if (!COMBINE) { if (hi == 0) dec.lsepart(cur)[rw0 + r32] = wsf[r32]; }
        cur = nxt;
#if DIAG_MODE>=30 && DIAG_MODE<40
        if (!COMBINE && lane == 0) wgd[2] = wgd[2] + 1ull;
#endif
    }
#if DIAG_MODE>=30 && DIAG_MODE<40
    if (!COMBINE && wid == 0 && lane == 0) { const unsigned long long c_ = wgd[2]; wsf[0] = (float)wgd[1] / (float)(c_ ? c_ : 1ull) * 0.125f; }
#endif
    asm volatile("s_waitcnt vmcnt(0) lgkmcnt(0)\n\ts_barrier" ::: "memory");
#undef WIN_ISSUE_K
#undef WIN_ISSUE_V
#undef WIN_ISSUE_Q
}
#undef WIN_WAITV
#undef WIN_BAR
}

constexpr int NWAVES = 8;
constexpr int BATCH = 8, SEQ = 4096, D = 1024, M = BATCH * SEQ;
constexpr int N0A = 6144, N0B = 4096, N1 = 4096;
constexpr float RMS_EPS = 1e-6f;
constexpr float QSCALE = 0.125f * 1.4426950408889634f;
constexpr int N_PHASES = 11;
#ifndef PROBE_EPI2
#define PROBE_EPI2 0
#endif
#ifndef PROBE_P5DUMMY
#define PROBE_P5DUMMY 0
#endif
#ifndef GEMM_STAGGER_TICKS
#define GEMM_STAGGER_TICKS 0
#endif
#ifndef PROBE_X2
#define PROBE_X2 0
#endif
#ifndef PROBE_REP
#define PROBE_REP 0
#endif

constexpr size_t MiB = 1u << 20;
constexpr size_t WS_CTL = 0, CTL_ZERO_BYTES = 1 * MiB;
constexpr size_t WS_ROPE = 1 * MiB;
constexpr size_t WS_LSE = 2 * MiB;
constexpr size_t WS_W0 = 8 * MiB, WS_WO0 = 28 * MiB, WS_W1 = 30 * MiB, WS_WO1 = 38 * MiB;
constexpr size_t WS_U = 40 * MiB;
constexpr size_t WS_PROJ = 104 * MiB, SEC_BYTES = 64 * MiB;
constexpr size_t SEC_ELEMS = SEC_BYTES / 2;
constexpr size_t WS_Y = WS_PROJ + 4 * SEC_BYTES;
constexpr size_t WS_T = WS_PROJ + 5 * SEC_BYTES;
constexpr size_t WS_END = 488 * MiB;
constexpr int CW_TMO = 0, CW_CODE = 1, CW_DIAG = 64, CW_BAR = 4096;

constexpr int RING_OFF = 0, RING_BYTES = 149504;
constexpr int LDSCTL_OFF = RING_BYTES, MISC_OFF = LDSCTL_OFF + 320;
constexpr int LDS_BYTES = 153600;
static_assert(MISC_OFF + 128 <= LDS_BYTES && pg8::STAGE_BYTES <= RING_BYTES && win::WIN_LDS_BYTES <= RING_BYTES && attn_body::LDS_BYTES + 512 <= RING_BYTES, "LDS map");

#define GAS __attribute__((address_space(1)))
#define LAS __attribute__((address_space(3)))
typedef unsigned short bf16;
typedef unsigned v4u __attribute__((ext_vector_type(4)));
typedef float f32x4 __attribute__((ext_vector_type(4)));
typedef short bf16x8 __attribute__((ext_vector_type(8)));
typedef GAS unsigned gu32;
typedef GAS unsigned long long gu64;
#define RLX_AGENT __ATOMIC_RELAXED, __HIP_MEMORY_SCOPE_AGENT
#define LDS_WAIT() asm volatile("s_waitcnt lgkmcnt(0)" ::: "memory")
#define VM_WAIT() asm volatile("s_waitcnt vmcnt(0)" ::: "memory")
__device__ __forceinline__ unsigned long long rt() { return __builtin_amdgcn_s_memrealtime(); }
__device__ __forceinline__ unsigned f2bf(float f) { unsigned u = __builtin_bit_cast(unsigned, f); return (u + 0x7fffu + ((u >> 16) & 1u)) >> 16; }
__device__ __forceinline__ unsigned pk2(float lo, float hi) { return f2bf(lo) | (f2bf(hi) << 16); }

#define XB_TMO      128
#define XB_XCNT(j)  (256  + 64 * (j))
#define XB_XSUB(j)  (1280 + 64 * (j))
#define XB_XGEN(j)  (2304 + 64 * (j))
#define XB_TOP      3328
#define XB_TOPGEN   3392
#define XCD_BAR_WORDS 3456
#define XB_SPIN_CAP (1u << 18)

__device__ __forceinline__ unsigned xb_ld(unsigned* p)              { return __hip_atomic_load(p, __ATOMIC_RELAXED, __HIP_MEMORY_SCOPE_AGENT); }
__device__ __forceinline__ unsigned xb_add(unsigned* p, unsigned v) { return __hip_atomic_fetch_add(p, v, __ATOMIC_RELAXED, __HIP_MEMORY_SCOPE_AGENT); }
__device__ __forceinline__ unsigned xb_xcc_id() { return (unsigned)__builtin_amdgcn_s_getreg((3 << 11) | 20) & 0xFu; }
#define XB_SPIN(cond, bar) do { unsigned _sp = 0; while (cond) { __builtin_amdgcn_s_sleep(1); \
    if ((++_sp & 255u) == 0u) { if (xb_ld(&(bar)[XB_TMO])) break; if (_sp > XB_SPIN_CAP) { atomicAdd(&(bar)[XB_TMO], 1u); break; } } } } while (0)

struct XcdBarrier {
    unsigned* bar; unsigned x;
    volatile LAS unsigned* st;
};

__device__ __forceinline__ XcdBarrier xcd_barrier_post(unsigned* bar, volatile LAS unsigned* st) {
    XcdBarrier b; b.bar = bar; b.x = xb_xcc_id(); b.st = st;
    if (threadIdx.x == 0) (void)xb_add(&bar[XB_XCNT(b.x)], 1u);
    return b;
}
__device__ __forceinline__ void xcd_barrier_complete(unsigned* bar, unsigned x, unsigned& nloc, unsigned& nx) {
    const unsigned G = gridDim.x * gridDim.y * gridDim.z;
    unsigned sum, cnt, mine, sp = 0u;
    for (;;) {
        sum = 0u; cnt = 0u; mine = 0u;
#pragma unroll
        for (unsigned j = 0; j < 16; ++j) { const unsigned c = xb_ld(&bar[XB_XCNT(j)]); sum += c; cnt += (c > 0u) ? 1u : 0u; mine = (j == x) ? c : mine; }
        if (sum == G) break;
        __builtin_amdgcn_s_sleep(1);
        if ((++sp & 255u) == 0u) { if (xb_ld(&bar[XB_TMO])) break; if (sp > XB_SPIN_CAP) { atomicAdd(&bar[XB_TMO], 1u); break; } }
    }
    nloc = mine > 0u ? mine : 1u; nx = cnt > 0u ? cnt : 1u;
}

__device__ __forceinline__ void xcd_barrier(const XcdBarrier& b) {
    asm volatile("s_waitcnt vmcnt(0)" ::: "memory");
    __syncthreads();
    if (threadIdx.x == 0) {
        unsigned* bar = b.bar;
        __builtin_amdgcn_s_waitcnt(0);
        unsigned nloc = b.st[0], nx = b.st[1];
        if (nloc == 0u) { xcd_barrier_complete(bar, b.x, nloc, nx); b.st[0] = nloc; b.st[1] = nx; }
        const unsigned old = xb_add(&bar[XB_XSUB(b.x)], 1u);
        const unsigned gen = old / nloc;
        if (old + 1u == (gen + 1u) * nloc) {
            __builtin_amdgcn_fence(__ATOMIC_RELEASE, "agent");
            asm volatile("s_waitcnt vmcnt(0)" ::: "memory");
            const unsigned og = xb_add(&bar[XB_TOP], 1u);
            const unsigned tg = og / nx;
            if (og + 1u == (tg + 1u) * nx) xb_add(&bar[XB_TOPGEN], 1u);
            else XB_SPIN(xb_ld(&bar[XB_TOPGEN]) == tg, bar);
            __builtin_amdgcn_fence(__ATOMIC_ACQUIRE, "agent");
            xb_add(&bar[XB_XGEN(b.x)], 1u);
            asm volatile("s_waitcnt vmcnt(0)" ::: "memory");
        } else {
            XB_SPIN(xb_ld(&bar[XB_XGEN(b.x)]) == gen, bar);
            __builtin_amdgcn_fence(__ATOMIC_ACQUIRE, "agent");
            asm volatile("s_waitcnt vmcnt(0)" ::: "memory");
        }
    }
    __syncthreads();
}


struct Frame {
    LAS unsigned char* lds; volatile LAS unsigned* MISC; gu32* ctl;
    int tid, lane, wave, vcu, G;
};

#define WS_DPP(v, ctrl) ((v) + __builtin_bit_cast(float, __builtin_amdgcn_update_dpp(0, __builtin_bit_cast(int, (v)), (ctrl), 0xF, 0xF, true)))
__device__ __forceinline__ float wave_sum(float v) {
    v = WS_DPP(v, 0xB1); v = WS_DPP(v, 0x4E); v = WS_DPP(v, 0x141); v = WS_DPP(v, 0x140);
    { const auto r = __builtin_amdgcn_permlane16_swap(__float_as_uint(v), __float_as_uint(v), false, false); v = __uint_as_float(r[0]) + __uint_as_float(r[1]); }
    { const auto r = __builtin_amdgcn_permlane32_swap(__float_as_uint(v), __float_as_uint(v), false, false); v = __uint_as_float(r[0]) + __uint_as_float(r[1]); }
    return v;
}
__device__ __forceinline__ int map_rope64(int d) { return (d & 15) | ((d & 16) << 1) | ((d & 32) >> 1); }
__device__ __forceinline__ int map_plain32(int c) { return (c & ~31) | ((c & 4) << 2) | ((c & 24) >> 1) | (c & 3); }
template <int MODE> __device__ __forceinline__ int wrow(int c) {
    if (MODE == 2) return map_plain32(c);
    const int sec = c >> 10, wi = c & 1023;
    if (MODE == 1) return (sec << 10) + ((sec < 2) ? ((wi & ~63) | map_rope64(wi & 63)) : map_plain32(wi));
    const int dsec = (int)((0x9548327106ull >> (4 * sec)) & 15ull);
    return (dsec << 10) + ((sec < 6) ? ((wi & ~63) | map_rope64(wi & 63)) : map_plain32(wi));
}
template <int MODE> __device__ __forceinline__ void p0_transpose_item(const float* W, int K, int N, bf16* WT, LAS float* scr, int item, int lane) {
    const int nblk = N / 32, kb = item / nblk, nb = item % nblk, k0 = 64 * kb, n0 = 32 * nb;
#pragma unroll 8
    for (int i = 0; i < 32; ++i) { const int kk = 2 * i + (lane >> 5); scr[kk * 33 + (lane & 31)] = W[(size_t)(k0 + kk) * N + n0 + (lane & 31)]; }
    LDS_WAIT(); asm volatile("" ::: "memory");
    const int c = lane & 7;
#pragma unroll
    for (int j = 0; j < 4; ++j) { const int n = (lane >> 3) + 8 * j; const LAS float* s = scr + (8 * c) * 33 + n;
        v4u o; o.x = pk2(s[0 * 33], s[1 * 33]); o.y = pk2(s[2 * 33], s[3 * 33]); o.z = pk2(s[4 * 33], s[5 * 33]); o.w = pk2(s[6 * 33], s[7 * 33]);
        *(GAS v4u*)(WT + (size_t)wrow<MODE>(n0 + n) * K + k0 + 8 * c) = o; }
    LDS_WAIT(); asm volatile("" ::: "memory");
}
__device__ __forceinline__ f32x4 bf4_to_f32(unsigned long long w) { const unsigned lo = (unsigned)w, hi = (unsigned)(w >> 32); f32x4 r; r.x = __uint_as_float(lo << 16); r.y = __uint_as_float(lo & 0xffff0000u); r.z = __uint_as_float(hi << 16); r.w = __uint_as_float(hi & 0xffff0000u); return r; }
__device__ __forceinline__ unsigned long long f32_to_bf4(f32x4 v) { return (unsigned long long)pk2(v.x, v.y) | ((unsigned long long)pk2(v.z, v.w) << 32); }
__device__ __forceinline__ float ssq4(const f32x4 (&v)[4]) { float s = 0.f;
#pragma unroll
    for (int j = 0; j < 4; ++j) s += (v[j].x * v[j].x + v[j].y * v[j].y) + (v[j].z * v[j].z + v[j].w * v[j].w);
    return s; }
constexpr int RB = 4;
__device__ __forceinline__ void rms_rows_to_bf16(const float* x, const float* g, bf16* U, int gw, int NGW, int lane) {
    f32x4 gv[4];
#pragma unroll
    for (int j = 0; j < 4; ++j) gv[j] = ((const GAS f32x4*)g + lane)[64 * j];
    const bool ctg_ = (M % NGW) == 0; const int rpw_ = M / NGW;
    for (int m0 = ctg_ ? gw * rpw_ : gw, me_ = ctg_ ? (gw + 1) * rpw_ : M; m0 < me_; m0 += ctg_ ? RB : RB * NGW) {
        f32x4 v[RB][4];
#pragma unroll
        for (int r = 0; r < RB; ++r) { const int m = m0 + (ctg_ ? r : r * NGW); if (m < me_) {
#pragma unroll
            for (int j = 0; j < 4; ++j) v[r][j] = ((const GAS f32x4*)(x + (size_t)m * D) + lane)[64 * j]; } }
#pragma unroll
        for (int r = 0; r < RB; ++r) { const int m = m0 + (ctg_ ? r : r * NGW); if (m < me_) {
            const float rs = 1.f / sqrtf(wave_sum(ssq4(v[r])) * (1.f / D) + RMS_EPS);
            GAS unsigned long long* o8 = (GAS unsigned long long*)(U + (size_t)m * D) + lane;
#pragma unroll
            for (int j = 0; j < 4; ++j) o8[64 * j] = f32_to_bf4(v[r][j] * rs * gv[j]); } }
    }
}
__device__ __forceinline__ void post_rows0(const float* x, bf16* T_h, const float* gpost, const float* gpre, bf16* U, int gw, int NGW, int lane) {
    f32x4 gp4[4], gq4[4];
#pragma unroll
    for (int j = 0; j < 4; ++j) { gp4[j] = ((const GAS f32x4*)gpost + lane)[64 * j]; gq4[j] = ((const GAS f32x4*)gpre + lane)[64 * j]; }
    const bool ctg_ = (M % NGW) == 0; const int rpw_ = M / NGW;
    for (int m0 = ctg_ ? gw * rpw_ : gw, me_ = ctg_ ? (gw + 1) * rpw_ : M; m0 < me_; m0 += ctg_ ? RB : RB * NGW) {
        f32x4 b[RB][4]; unsigned long long tw[RB][4];
#pragma unroll
        for (int r = 0; r < RB; ++r) { const int m = m0 + (ctg_ ? r : r * NGW); if (m < me_) {
#pragma unroll
            for (int j = 0; j < 4; ++j) { b[r][j] = ((const GAS f32x4*)(x + (size_t)m * D) + lane)[64 * j]; tw[r][j] = ((const GAS unsigned long long*)(T_h + (size_t)m * D) + lane)[64 * j]; } } }
#pragma unroll
        for (int r = 0; r < RB; ++r) { const int m = m0 + (ctg_ ? r : r * NGW); if (m < me_) {
            f32x4 t[4];
#pragma unroll
            for (int j = 0; j < 4; ++j) t[j] = bf4_to_f32(tw[r][j]);
            const float rs = 1.f / sqrtf(wave_sum(ssq4(t)) * (1.f / D) + RMS_EPS);
            f32x4 h[4];
#pragma unroll
            for (int j = 0; j < 4; ++j) h[j] = b[r][j] + t[j] * rs * gp4[j];
            GAS unsigned long long* ho = (GAS unsigned long long*)(T_h + (size_t)m * D) + lane;
#pragma unroll
            for (int j = 0; j < 4; ++j) ho[64 * j] = f32_to_bf4(h[j]);
            const float r2 = 1.f / sqrtf(wave_sum(ssq4(h)) * (1.f / D) + RMS_EPS);
            GAS unsigned long long* o8 = (GAS unsigned long long*)(U + (size_t)m * D) + lane;
#pragma unroll
            for (int j = 0; j < 4; ++j) o8[64 * j] = f32_to_bf4(h[j] * r2 * gq4[j]); } }
    }
}
__device__ __forceinline__ void post_rows1(const bf16* H, const bf16* T1, const float* gpost, float* out, int gw, int NGW, int lane) {
    f32x4 gp4[4];
#pragma unroll
    for (int j = 0; j < 4; ++j) gp4[j] = ((const GAS f32x4*)gpost + lane)[64 * j];
    const bool ctg_ = (M % NGW) == 0; const int rpw_ = M / NGW;
    for (int m0 = ctg_ ? gw * rpw_ : gw, me_ = ctg_ ? (gw + 1) * rpw_ : M; m0 < me_; m0 += ctg_ ? RB : RB * NGW) {
        unsigned long long hw[RB][4], tw[RB][4];
#pragma unroll
        for (int r = 0; r < RB; ++r) { const int m = m0 + (ctg_ ? r : r * NGW); if (m < me_) {
#pragma unroll
            for (int j = 0; j < 4; ++j) { hw[r][j] = ((const GAS unsigned long long*)(H + (size_t)m * D) + lane)[64 * j]; tw[r][j] = ((const GAS unsigned long long*)(T1 + (size_t)m * D) + lane)[64 * j]; } } }
#pragma unroll
        for (int r = 0; r < RB; ++r) { const int m = m0 + (ctg_ ? r : r * NGW); if (m < me_) {
            f32x4 t[4];
#pragma unroll
            for (int j = 0; j < 4; ++j) t[j] = bf4_to_f32(tw[r][j]);
            const float rs = 1.f / sqrtf(wave_sum(ssq4(t)) * (1.f / D) + RMS_EPS);
            GAS f32x4* oo = (GAS f32x4*)(out + (size_t)m * D) + lane;
#pragma unroll
            for (int j = 0; j < 4; ++j) oo[64 * j] = bf4_to_f32(hw[r][j]) + t[j] * rs * gp4[j]; } }
    }
}

struct WinDecA {
    const bf16* proj; bf16* part; float* lse;
    __device__ __forceinline__ win::Unit unit(int u) const { win::Unit U; U.g = 1 + (u >> 11); const int idx = u & 2047; U.bh = idx >> 4; const int blk = idx & 15; U.rho0 = blk * 256; U.first = (U.g == 2) || ((blk & 3) == 0); return U; }
    __device__ __forceinline__ const win::bf16* Q(const win::Unit& U) const { return (const win::bf16*)(proj + (size_t)(U.g - 1) * SEC_ELEMS + (size_t)U.bh * 4096 * 64); }
    __device__ __forceinline__ const win::bf16* K(const win::Unit& U) const { return (const win::bf16*)(proj + (size_t)(U.g + 1) * SEC_ELEMS + (size_t)U.bh * 4096 * 64); }
    __device__ __forceinline__ const win::bf16* V(const win::Unit& U) const { return (const win::bf16*)(proj + (size_t)(U.g + 3) * SEC_ELEMS + (size_t)U.bh * 4096 * 64); }
    __device__ __forceinline__ win::bf16* Opart(const win::Unit& U) const { return (win::bf16*)(part + (size_t)(U.g - 1) * SEC_ELEMS + (size_t)U.bh * 4096 * 64); }
    __device__ __forceinline__ float* lsepart(const win::Unit& U) const { return lse + (size_t)(U.g - 1) * (128 * 4096) + (size_t)U.bh * 4096; }
    __device__ __forceinline__ const win::bf16* O1h(const win::Unit&) const { return nullptr; }
    __device__ __forceinline__ const win::bf16* O2h(const win::Unit&) const { return nullptr; }
    __device__ __forceinline__ const float* L1h(const win::Unit&) const { return nullptr; }
    __device__ __forceinline__ const float* L2h(const win::Unit&) const { return nullptr; }
    __device__ __forceinline__ const win::bf16* gate(const win::Unit&) const { return nullptr; }
    __device__ __forceinline__ win::bf16* Yp(const win::Unit&) const { return nullptr; }
};
struct WinDecB {
    const bf16* proj; const bf16* part; const float* lse; bf16* Y;
    __device__ __forceinline__ win::Unit unit(int u) const { win::Unit U; U.g = 0; U.bh = u >> 4; const int blk = u & 15; U.rho0 = blk * 256; U.first = (blk == 0); return U; }
    __device__ __forceinline__ const win::bf16* Q(const win::Unit& U) const { return (const win::bf16*)(proj + (size_t)U.bh * 4096 * 64); }
    __device__ __forceinline__ const win::bf16* K(const win::Unit& U) const { return (const win::bf16*)(proj + SEC_ELEMS + (size_t)U.bh * 4096 * 64); }
    __device__ __forceinline__ const win::bf16* V(const win::Unit& U) const { return (const win::bf16*)(proj + 2 * SEC_ELEMS + (size_t)U.bh * 4096 * 64); }
    __device__ __forceinline__ win::bf16* Opart(const win::Unit&) const { return nullptr; }
    __device__ __forceinline__ float* lsepart(const win::Unit&) const { return nullptr; }
    __device__ __forceinline__ const win::bf16* O1h(const win::Unit& U) const { return (const win::bf16*)(part + (size_t)U.bh * 4096 * 64); }
    __device__ __forceinline__ const win::bf16* O2h(const win::Unit& U) const { return (const win::bf16*)(part + SEC_ELEMS + (size_t)U.bh * 4096 * 64); }
    __device__ __forceinline__ const float* L1h(const win::Unit& U) const { return lse + (size_t)U.bh * 4096; }
    __device__ __forceinline__ const float* L2h(const win::Unit& U) const { return lse + (size_t)(128 * 4096) + (size_t)U.bh * 4096; }
    __device__ __forceinline__ const win::bf16* gate(const win::Unit& U) const { return (const win::bf16*)(proj + 3 * SEC_ELEMS + (size_t)(U.bh >> 4) * SEQ * D + (U.bh & 15) * 64); }
    __device__ __forceinline__ win::bf16* Yp(const win::Unit& U) const { return (win::bf16*)(Y + (size_t)(U.bh >> 4) * SEQ * D + (U.bh & 15) * 64); }
};
__device__ __forceinline__ void gemm_stagger(int vcu) {
    if (GEMM_STAGGER_TICKS > 0) { const unsigned long long t0 = rt(), w = (unsigned long long)(vcu & 3) * GEMM_STAGGER_TICKS; while (rt() - t0 < w) __builtin_amdgcn_s_sleep(8); }
}
struct Args { const float* in[12]; float* out; unsigned char* ws; int ph_lo, ph_hi; int rep, pad; };
__global__ void __launch_bounds__(NWAVES * 64, 2) mega_fwd(Args args) {
    extern __shared__ __attribute__((aligned(16))) unsigned char lds[];
    cg::grid_group grid = cg::this_grid();
    Frame F;
    F.lds = (LAS unsigned char*)lds; F.MISC = (volatile LAS unsigned*)(F.lds + MISC_OFF);
    F.tid = threadIdx.x; F.lane = F.tid & 63; F.wave = __builtin_amdgcn_readfirstlane(F.tid >> 6);
    F.G = gridDim.x; { const int bx = blockIdx.x; F.vcu = (F.G % 8 == 0) ? (bx % 8) * (F.G / 8) + bx / 8 : bx; }
    unsigned char* ws = args.ws;
    F.ctl = (gu32*)(ws + WS_CTL);
    const float* x = args.in[0]; const float* norm_pre = args.in[1]; const float* norm_post = args.in[2];
    const float* dil_w_in = args.in[3]; const float* dil_w_out = args.in[4]; const float* diff_w_in = args.in[5]; const float* diff_w_out = args.in[6];
    const float* lq1 = args.in[7]; const float* lk1 = args.in[8]; const float* lq2 = args.in[9]; const float* lk2 = args.in[10]; const float* subln = args.in[11];
    float* out = args.out;
    bf16* W0t = (bf16*)(ws + WS_W0); bf16* Wo0t = (bf16*)(ws + WS_WO0); bf16* W1t = (bf16*)(ws + WS_W1); bf16* Wo1t = (bf16*)(ws + WS_WO1);
    bf16* U = (bf16*)(ws + WS_U); bf16* PROJ = (bf16*)(ws + WS_PROJ); bf16* Y = (bf16*)(ws + WS_Y); bf16* T = (bf16*)(ws + WS_T);
    float* CS = (float*)(ws + WS_ROPE); float* LSE = (float*)(ws + WS_LSE);
    for (int u = F.tid; u < (LDS_BYTES - LDSCTL_OFF) / 4; u += NWAVES * 64) ((LAS unsigned*)(F.lds + LDSCTL_OFF))[u] = 0u;
    __syncthreads();
    XcdBarrier bar = xcd_barrier_post((unsigned*)(F.ctl + CW_BAR), F.MISC + 8);
    const int lo = args.ph_lo, hi = args.ph_hi;
    if (DIAG_MODE >= 20 && F.tid == 0) { const unsigned long long r_ = __builtin_amdgcn_s_memrealtime(); F.MISC[22] = (unsigned)r_; F.MISC[23] = (unsigned)(r_ >> 32); }
#define DIAG_PH(k) do { if (DIAG_MODE == 20 + (k) && blockIdx.x == 0 && F.tid == 0) { const unsigned long long r0_ = (unsigned long long)F.MISC[22] | ((unsigned long long)F.MISC[23] << 32); F.MISC[20] = __float_as_uint((float)(__builtin_amdgcn_s_memrealtime() - r0_) * 0.01f); } } while (0)
#define IN(k) (lo <= (k) && (k) < hi)
#define REP(k) for (int rr_ = 0; rr_ <= ((PROBE_REP >> (k)) & 1); ++rr_)
#define BOTH(k) (IN(k) && IN((k) + 1))
#define GRID_BAR() xcd_barrier(bar)
    const int gw = F.vcu * NWAVES + F.wave, NGW = F.G * NWAVES;

    if (IN(0)) {
        REP(0) {
        LAS float* scr = (LAS float*)(F.lds + RING_OFF + F.wave * 16384);
        constexpr int I_W0 = (D / 64) * (10240 / 32), I_WO = (D / 64) * (D / 32), I_W1 = (D / 64) * (N1 / 32);
        constexpr int NITEMS = I_W0 + 2 * I_WO + I_W1;
        for (int it = gw; it < NITEMS; it += NGW) {
            int r = it;
            if (r < I_W0) { p0_transpose_item<0>(dil_w_in, D, 10240, W0t, scr, r, F.lane); continue; } r -= I_W0;
            if (r < I_W1) { p0_transpose_item<1>(diff_w_in, D, N1, W1t, scr, r, F.lane); continue; } r -= I_W1;
            if (r < I_WO) { p0_transpose_item<2>(dil_w_out, D, D, Wo0t, scr, r, F.lane); continue; } r -= I_WO;
            p0_transpose_item<2>(diff_w_out, D, D, Wo1t, scr, r, F.lane);
        }
        rms_rows_to_bf16(x, norm_pre, U, gw, NGW, F.lane);
        }
        if (BOTH(0)) { if (args.ph_lo < 0) grid.sync();
                       else GRID_BAR(); }
        DIAG_PH(0);
    }
    if (IN(1)) {
        if (DIAG_MODE == 2 && F.tid == 0) { const unsigned long long c_ = __builtin_amdgcn_s_memtime(), r_ = __builtin_amdgcn_s_memrealtime(); F.MISC[16] = (unsigned)c_; F.MISC[17] = (unsigned)(c_ >> 32); F.MISC[18] = (unsigned)r_; F.MISC[19] = (unsigned)(r_ >> 32); }
        REP(1) {
        gemm_stagger(F.vcu);
        pg8::Gemm g{U, W0t, M, N0A, D}; pg8::StaticOrder S; S.init(M, N0A, F.G, (int)blockIdx.x, 1 + ((PROBE_X2 >> 1) & 1));
        pg8::EpiProj E{PROJ, SEC_ELEMS, 0x0fu, 0x03u, 0x3fu, 0x424242u, 0x0cu, CS, QSCALE};
        pg8::gemm_phase<pg8::EpiProj, pg8::StaticOrder, false, true>(F.lds + RING_OFF, g, S, E);
        }
        if (DIAG_MODE == 2 && blockIdx.x == 0 && F.tid == 0) { const unsigned long long dc0_ = (unsigned long long)F.MISC[16] | ((unsigned long long)F.MISC[17] << 32), dr0_ = (unsigned long long)F.MISC[18] | ((unsigned long long)F.MISC[19] << 32);
            const unsigned long long dc = __builtin_amdgcn_s_memtime() - dc0_, dr = __builtin_amdgcn_s_memrealtime() - dr0_; F.MISC[20] = __float_as_uint((float)dc / (float)dr * 100.0f - 1000.0f); }
        if (BOTH(1)) GRID_BAR();
        DIAG_PH(1);
    }
    if (IN(2)) {
        REP(2) {
        const int ub = (int)(((long)4096 * F.vcu) / F.G), ue = (int)(((long)4096 * (F.vcu + 1)) / F.G);
        const WinDecA dec{PROJ, (bf16*)out, LSE};
        win::phase<false, WinDecA>(ub, ue, dec, (char*)lds + RING_OFF);
        if (DIAG_MODE >= 30 && DIAG_MODE < 40 && blockIdx.x == 0 && F.tid == 0) F.MISC[20] = __float_as_uint(*(volatile LAS float*)(F.lds + RING_OFF + win::LWS));
        }
        if (BOTH(2)) GRID_BAR();
        DIAG_PH(2);
    }
    if (IN(3)) {
        REP(3) {
        gemm_stagger(F.vcu);
        pg8::Gemm g{U, W0t + (size_t)N0A * D, M, N0B, D}; pg8::StaticOrder S; S.init(M, N0B, F.G, (int)blockIdx.x, 1 + ((PROBE_X2 >> 3) & 1));
        pg8::EpiProj E{PROJ, SEC_ELEMS, 0x03u, 0x01u, 0x07u, 0x0u, 0x02u, CS, QSCALE};
        pg8::gemm_phase<pg8::EpiProj, pg8::StaticOrder, false, true>(F.lds + RING_OFF, g, S, E);
        }
        if (BOTH(3)) GRID_BAR();
        DIAG_PH(3);
    }
    if (IN(4)) {
        REP(4) {
        const int ub = (int)(((long)2048 * F.vcu) / F.G), ue = (int)(((long)2048 * (F.vcu + 1)) / F.G);
        const WinDecB dec{PROJ, (const bf16*)out, LSE, Y};
        win::phase<true, WinDecB>(ub, ue, dec, (char*)lds + RING_OFF);
        }
        if (BOTH(4)) GRID_BAR();
        DIAG_PH(4);
    }
    if (IN(5)) {
        REP(5) {
        pg8::Gemm g{Y, Wo0t, M, D, D}; pg8::StaticOrder S; S.init(M, D, F.G, (int)blockIdx.x, 1 + ((PROBE_X2 >> 5) & 1));
        pg8::EpiProj E{T, 0, 0u, 0u, 0u, 0u, 0u, CS, 1.0f};
        pg8::gemm_phase<pg8::EpiProj, pg8::StaticOrder, false, true>(F.lds + RING_OFF, g, S, E);
        }
        if (BOTH(5)) GRID_BAR();
        DIAG_PH(5);
    }
    if (IN(6)) {
        REP(6) {
        int t_ = threadIdx.x; asm volatile("" : "+v"(t_));
        post_rows0(x, T, norm_post, norm_pre + D, U, gw, NGW, t_ & 63);
        }
        if (BOTH(6)) GRID_BAR();
        DIAG_PH(6);
    }
    if (IN(7)) {
        REP(7) {
        gemm_stagger(F.vcu);
        pg8::Gemm g{U, W1t, M, N1, D}; pg8::StaticOrder S; S.init(M, N1, F.G, (int)blockIdx.x, 1 + ((PROBE_X2 >> 7) & 1));
        pg8::EpiProj E{PROJ, SEC_ELEMS, 0x03u, 0x01u, 0x0u, 0x0u, 0x0u, CS, QSCALE};
        pg8::gemm_phase<pg8::EpiProj, pg8::StaticOrder, false, true>(F.lds + RING_OFF, g, S, E);
        }
        if (BOTH(7)) GRID_BAR();
        DIAG_PH(7);
    }
    if (IN(8)) {
        unsigned long long dc0_ = 0, dr0_ = 0; if (DIAG_MODE == 1 || DIAG_MODE == 12 || DIAG_MODE == 13) { dc0_ = __builtin_amdgcn_s_memtime(); dr0_ = __builtin_amdgcn_s_memrealtime(); }
        REP(8) {
        int t_ = threadIdx.x; asm volatile("" : "+v"(t_)); const int ln_ = t_ & 63;
        float d1 = lq1[ln_] * lk1[ln_], d2 = lq2[ln_] * lk2[ln_]; d1 = wave_sum(d1); d2 = wave_sum(d2);
        const float lambda_init = 0.8f - 0.6f * 0.74081822068f;
        const float lam = __expf(d1) - __expf(d2) + lambda_init;
        attn_body::diff_rec_t rec = (attn_body::diff_rec_t)(F.lds + RING_OFF + attn_body::LDS_BYTES + F.wave * 64);
        rec[0] = 0ull; rec[1] = (unsigned long long)subln;
        rec[4] = (unsigned long long)__float_as_uint(lam) | ((unsigned long long)__float_as_uint(1.0f - lambda_init) << 32); rec[5] = 0ull; rec[6] = 0ull;
        const int nun = (F.G == 256) ? 4 : (1024 - F.vcu + F.G - 1) / F.G;
        for (int ii = 0; ii < nun * (1 + ((PROBE_X2 >> 8) & 1)); ++ii) {
            const int i = ii % nun; int bh, qb;
            if (F.G == 256) { const int s = F.vcu & 3; bh = F.vcu >> 2; qb = (i == 0) ? 15 - s : (i == 1) ? 8 + s : (i == 2) ? 7 - s : s; }
            else { const int u = F.vcu + i * F.G; bh = u >> 4; qb = 15 - (u & 15); }
            const int b = bh >> 3, h = bh & 7; const size_t bo = (size_t)b * SEQ * D;
            { unsigned ra_ = (unsigned)(RING_OFF + attn_body::LDS_BYTES) + (unsigned)F.wave * 64u; asm volatile("" : "+s"(ra_));
              attn_body::diff_rec_t rc_ = (attn_body::diff_rec_t)(F.lds + ra_);
              rc_[2] = (unsigned long long)(PROJ + 3 * SEC_ELEMS + bo + h * 128); rc_[3] = (unsigned long long)(Y + bo + h * 128); }
            for (int pp = 0; pp < 2 * (1 + PROBE_P5DUMMY); ++pp) {
                const bool dummy = PROBE_P5DUMMY && (pp & 1); const int c = dummy ? 4 : (PROBE_P5DUMMY ? (pp >> 1) : pp);
                attn_body::attn_unit<8>(dummy ? 0 : qb * 256, (const attn_body::bf16*)(PROJ + bo + (2 * h + (c & 1)) * 64), (const attn_body::bf16*)(PROJ + SEC_ELEMS + bo + (2 * h + (c & 1)) * 64),
                                        (const attn_body::bf16*)(PROJ + 2 * SEC_ELEMS + bo + h * 128), (char*)lds + RING_OFF, c);
            }
        }
        }
        if (DIAG_MODE >= 3 && DIAG_MODE < 12 && blockIdx.x == 0 && F.tid == 0) { attn_body::diff_rec_t rq_ = (attn_body::diff_rec_t)(F.lds + RING_OFF + attn_body::LDS_BYTES); const unsigned long long sm = rq_[5], cn = rq_[6]; F.MISC[20] = __float_as_uint((float)sm / (float)(cn ? cn : 1ull) * 0.5f); }
        if (DIAG_MODE == 1 && blockIdx.x == 0 && F.tid == 0) { const unsigned long long dc = __builtin_amdgcn_s_memtime() - dc0_, dr = __builtin_amdgcn_s_memrealtime() - dr0_; F.MISC[20] = __float_as_uint((float)dc / (float)dr * 100.0f - 1000.0f); }
        if (DIAG_MODE == 13 && blockIdx.x == 0 && F.tid == 0) F.MISC[20] = __float_as_uint((float)(__builtin_amdgcn_s_memrealtime() - dr0_) * 0.01f);
        if (BOTH(8)) GRID_BAR();
        DIAG_PH(8);
        if (DIAG_MODE == 12 && blockIdx.x == 0 && F.tid == 0) F.MISC[20] = __float_as_uint((float)(__builtin_amdgcn_s_memrealtime() - dr0_) * 0.01f);
    }
    if (IN(9)) {
        REP(9) {
        pg8::Gemm g{Y, Wo1t, M, D, D}; pg8::StaticOrder S; S.init(M, D, F.G, (int)blockIdx.x, 1 + ((PROBE_X2 >> 9) & 1));
        pg8::EpiProj E{PROJ, 0, 0u, 0u, 0u, 0u, 0u, CS, 1.0f};
        pg8::gemm_phase<pg8::EpiProj, pg8::StaticOrder, false, true>(F.lds + RING_OFF, g, S, E);
        }
        if (BOTH(9)) GRID_BAR();
        DIAG_PH(9);
    }
    if (IN(10)) {
        int t_ = threadIdx.x; asm volatile("" : "+v"(t_));
        post_rows1(T, PROJ, norm_post + D, out, gw, NGW, t_ & 63);
    }
    if (DIAG_MODE != 0 && blockIdx.x == 0 && F.tid == 0) { const unsigned long long t0 = rt(), w = (unsigned long long)(__uint_as_float(F.MISC[20]) * 100.0f); while (rt() - t0 < w) __builtin_amdgcn_s_sleep(10); }
#undef IN
#undef BOTH
#undef GRID_BAR
}

static int launch_mega(void* const* d_in, void* d_out, void* d_ws, size_t ws_size, hipStream_t stream, int ph_lo, int ph_hi, int rep) {
    static int grid = 0;
    if (grid == 0) {
        if (ws_size < WS_END) { fprintf(stderr, "kernel_launch: needs %zu bytes of workspace, got %zu; nothing launched\n", (size_t)WS_END, ws_size); grid = -1; return -1; }
        int dev = 0, cus = 0, per_cu = 0;
        if (hipGetDevice(&dev) != hipSuccess || hipDeviceGetAttribute(&cus, hipDeviceAttributeMultiprocessorCount, dev) != hipSuccess) { grid = -1; return -1; }
        if (hipFuncSetAttribute((const void*)mega_fwd, hipFuncAttributeMaxDynamicSharedMemorySize, LDS_BYTES) != hipSuccess) { fprintf(stderr, "kernel_launch: hipFuncSetAttribute failed\n"); grid = -1; return -1; }
        if (hipOccupancyMaxActiveBlocksPerMultiprocessor(&per_cu, (const void*)mega_fwd, NWAVES * 64, LDS_BYTES) != hipSuccess || per_cu < 1) { fprintf(stderr, "kernel_launch: occupancy query says %d blocks per CU\n", per_cu); (void)hipGetLastError(); grid = -1; return -1; }
        grid = cus;
    }
    if (grid < 0) return -1;
    if (hipMemsetAsync((char*)d_ws + WS_CTL, 0, CTL_ZERO_BYTES, stream) != hipSuccess) return -1;
    Args a{};
    for (int i = 0; i < 12; ++i) a.in[i] = (const float*)d_in[i];
    a.out = (float*)d_out; a.ws = (unsigned char*)d_ws; a.ph_lo = ph_lo; a.ph_hi = ph_hi; a.rep = rep;
    void* kargs[] = {&a};
    const hipError_t e = hipLaunchCooperativeKernel((const void*)mega_fwd, dim3(grid), dim3(NWAVES * 64), kargs, LDS_BYTES, stream);
    if (e != hipSuccess) { fprintf(stderr, "kernel_launch: cooperative launch failed: %s (grid %d)\n", hipGetErrorString(e), grid); return -1; }
    return 0;
}
extern "C" void kernel_launch(void* const* d_in, const int* in_sizes, int n_in, void* d_out, int out_size, void* d_ws, size_t ws_size, hipStream_t stream) {
    (void)in_sizes; (void)n_in; (void)out_size;
    launch_mega(d_in, d_out, d_ws, ws_size, stream, 0, N_PHASES, PROBE_REP);
}
```

```cpp
#include <hip/hip_runtime.h>
#include <hip/hip_cooperative_groups.h>
#include <hip/hip_bf16.h>
#include <cstdio>
#include <cstdint>
#include <cmath>
namespace cg = cooperative_groups;
__device__ __forceinline__ int lane_now() { int l = (int)__builtin_amdgcn_mbcnt_hi(~0u, __builtin_amdgcn_mbcnt_lo(~0u, 0u)); asm volatile("" : "+v"(l)); return l; }
#ifndef PROBE_EPI2
#define PROBE_EPI2 0
#endif
#ifndef DIAG_MODE
#define DIAG_MODE 0
#endif
#ifndef PROBE_KLOOP2
#define PROBE_KLOOP2 0
#endif
#ifndef PROBE_P5DUMMY
#define PROBE_P5DUMMY 0
#endif
namespace pg8 {
#define PG8_LAS __attribute__((address_space(3)))
typedef unsigned short bf16_t;
typedef short bf16x8 __attribute__((ext_vector_type(8)));
typedef float f32x4 __attribute__((ext_vector_type(4)));
typedef unsigned u32x4 __attribute__((ext_vector_type(4)));
constexpr int BM = 256, BK = 64, HALF = 128, HTB = HALF * BK * 2  , STAGE_BYTES = 8 * HTB, NXCD = 8, WGM = 8;

__host__ __device__ __forceinline__ int lds_byte(int r, int c) { const int st = (r >> 4) * 2 + (c >> 5), rr = r & 15, cc = c & 31, ob = rr * 64 + cc * 2; return st * 1024 + (ob ^ (((ob >> 9) & 1) << 5)); }
__host__ __device__ __forceinline__ void stage_rc(int b, int& R, int& C) { const int st = b / 1024, sb = b % 1024, swz = sb ^ (((sb >> 9) & 1) << 5); R = (st >> 1) * 16 + swz / 64; C = (st & 1) * 32 + (swz % 64) / 2; }
__host__ __device__ __forceinline__ int perm32(int rho) { const int n = rho >> 4, i = rho & 15; return 8 * (i >> 2) + 4 * n + (i & 3); }

struct Unit { int pm, pn; };
struct Gemm { const bf16_t* A; const bf16_t* Bt; int M, N, K; };

struct StaticOrder {
    int nM, nN, nwg, G, c, rep;
    __host__ __device__ void init(int M, int N, int G_, int c_, int rep_ = 1) { nM = M / BM; nN = N / BM; nwg = nM * nN; G = G_; c = c_; rep = rep_; }
    __host__ __device__ bool next(int i, Unit& u) const {
        if (rep > 1) { const int per = nwg / G; if (i >= per * rep) return false; i %= per; }
        const long L = (long)i * G + c; if (L >= nwg) return false;
        int wgid = (int)L; { const int q = nwg / NXCD, r = nwg % NXCD, xcd = wgid % NXCD, off = wgid / NXCD; wgid = (xcd < r ? xcd * (q + 1) : r * (q + 1) + (xcd - r) * q) + off; }
        const int nig = WGM * nN, gid = wgid / nig, fm = gid * WGM, gsz = (nM - fm) < WGM ? (nM - fm) : WGM;
        u.pm = fm + ((wgid % nig) % gsz); u.pn = (wgid % nig) / gsz; return true;
    }
    __device__ __forceinline__ void a_ready(const Unit&) const {}
    __device__ __forceinline__ void done(const Unit&) const {}
};


__device__ __forceinline__ unsigned cvt_pk_bf16(float lo, float hi) { typedef float f2 __attribute__((ext_vector_type(2))); typedef __bf16 b2 __attribute__((ext_vector_type(2))); f2 v = {lo, hi}; b2 b = __builtin_convertvector(v, b2); return __builtin_bit_cast(unsigned, b); }
typedef unsigned u32x2 __attribute__((ext_vector_type(2)));
struct EpiProj {
    static constexpr bool PERM = false, AFTER_DRAIN = false;
    bf16_t* base; size_t sec_stride; unsigned ropemask, scalemask, hmmask, lgd4, kimgmask; const float* cs; float qscale;
    template <bool ROPE, bool HM, bool KIMG>
    __device__ __forceinline__ void tile(const f32x4 (&acc)[2][2][4][2], const Unit& u, int wr, int wc, int fr, int fq, bf16_t* sb, float sc, int lgd) const {
        const int row0 = u.pm * BM + wr * 64 + fr; const int bidx = (u.pm * BM) >> 12;
        const int w1 = wc & 1, hsub = wc >> 1;
        float Fh[4], Fl[4];
        if (ROPE) {
#pragma unroll
            for (int i = 0; i < 4; ++i) { const float F = __builtin_amdgcn_exp2f(-(float)(w1 * 16 + 4 * fq + i) * (13.287712379549449f / 32.0f)) * 0.15915494309189535f;
                Fh[i] = __uint_as_float(__float_as_uint(F) & 0xfffff000u); Fl[i] = F - Fh[i]; }
        }
#pragma unroll
        for (int ai = 0; ai < 2; ++ai)
#pragma unroll
            for (int m = 0; m < 4; ++m) {
                const int row = row0 + ai * HALF + m * 16; const int s = row & 4095;
                const int rho = ((s & ((1 << lgd) - 1)) << (12 - lgd)) + (s >> lgd);
#pragma unroll
                for (int bj = 0; bj < 2; ++bj) {
                    const int head = (u.pn & 3) * 4 + bj * 2 + hsub;
                    bf16_t* hb = sb + (size_t)(bidx * 16 + head) * (4096 * 64);
                    bf16_t* rp = sb + (size_t)row * 1024 + head * 64;
                    const f32x4 a0 = acc[ai][bj][m][0], a1 = acc[ai][bj][m][1];
                    if (ROPE) {
                        f32x4 cvv, svv;
#pragma unroll
                        for (int i = 0; i < 4; ++i) { const float ps = (float)s; const float rev = __builtin_amdgcn_fractf(ps * Fh[i]) + ps * Fl[i]; cvv[i] = __builtin_amdgcn_cosf(rev); svv[i] = __builtin_amdgcn_sinf(rev); }
                        const f32x4 lo = (a0 * cvv - a1 * svv) * sc, hi = (a1 * cvv + a0 * svv) * sc;
                        u32x2 wl, wh; wl.x = cvt_pk_bf16(lo[0], lo[1]); wl.y = cvt_pk_bf16(lo[2], lo[3]); wh.x = cvt_pk_bf16(hi[0], hi[1]); wh.y = cvt_pk_bf16(hi[2], hi[3]);
                        const auto sx = __builtin_amdgcn_permlane16_swap(wl.x, wh.x, false, false); const auto sy = __builtin_amdgcn_permlane16_swap(wl.y, wh.y, false, false);
                        u32x4 w; w.x = sx[0]; w.y = sy[0]; w.z = sx[1]; w.w = sy[1];
                        const int d0 = (fq & 1) * 32 + w1 * 16 + (fq >> 1) * 8;
                        if (!HM) *(u32x4*)(rp + d0) = w;
                        else if (KIMG) *(u32x4*)(hb + (rho >> 6) * 4096 + (d0 >> 3) * 512 + (rho & 63) * 8) = w;
                        else *(u32x4*)(hb + (rho >> 5) * 2048 + (d0 >> 3) * 256 + (rho & 31) * 8) = w;
                    } else {
                        u32x4 w; w.x = cvt_pk_bf16(a0[0], a0[1]); w.y = cvt_pk_bf16(a0[2], a0[3]); w.z = cvt_pk_bf16(a1[0], a1[1]); w.w = cvt_pk_bf16(a1[2], a1[3]);
                        if (!HM) *(u32x4*)(rp + w1 * 32 + 8 * fq) = w;
                        else *(u32x4*)(hb + (rho >> 6) * 4096 + w1 * 2048 + (rho & 63) * 32 + 8 * fq) = w;
                    }
                }
            }
    }
    __device__ __forceinline__ void operator()(const f32x4 (&acc)[2][2][4][2], const Unit& u, int wr, int wc, int fr, int fq) const {
        const int sec = u.pn >> 2; const bool rope = (ropemask >> sec) & 1u, hm = (hmmask >> sec) & 1u; const float sc = ((scalemask >> sec) & 1u) ? qscale : 1.0f;
        const int lgd = (int)((lgd4 >> (4 * sec)) & 15u);
        bf16_t* sb = base + (size_t)sec * sec_stride;
        const bool kimg = (kimgmask >> sec) & 1u;
        if (rope) { if (hm) { if (kimg) tile<true, true, true>(acc, u, wr, wc, fr, fq, sb, sc, lgd); else tile<true, true, false>(acc, u, wr, wc, fr, fq, sb, sc, lgd); } else tile<true, false, false>(acc, u, wr, wc, fr, fq, sb, sc, lgd); }
        else      { if (hm) tile<false, true, false>(acc, u, wr, wc, fr, fq, sb, sc, lgd); else tile<false, false, false>(acc, u, wr, wc, fr, fq, sb, sc, lgd); }
    }
};
template <class Epi, class Sched, bool ALIGN_EPI = false, bool SP2 = false>
__device__ __forceinline__ void gemm_phase(PG8_LAS unsigned char* lds, const Gemm g, const Sched& S, const Epi& E) {
    int tid_ = threadIdx.x; asm volatile("" : "+v"(tid_)); __builtin_assume(tid_ >= 0 && tid_ < 512);
    const int tid = tid_, wid = __builtin_amdgcn_readfirstlane(tid >> 6), lane = tid & 63, wr = wid >> 2, wc = wid & 3, fr = lane & 15, fq = lane >> 4;
    const int K = g.K, nt = K / BK;
    unsigned voffA[2], voffB[2];
#pragma unroll
    for (int i = 0; i < 2; ++i) { int R, C; stage_rc(tid * 16 + i * 8192, R, C); const int Rb = Epi::PERM ? ((R & ~31) + perm32(R & 31)) : R;
        voffA[i] = (unsigned)(R * K + C) * 2u; voffB[i] = (unsigned)(Rb * K + C) * 2u; }
    const size_t kstep = (size_t)(BK * 2);
    const size_t hstep = (size_t)HALF * K * 2;
    const size_t tstep = 2 * hstep;
    const unsigned ldsw = (unsigned)wid * 1024u;
    const int aoff = lds_byte(wr * 64 + fr, fq * 8), boff = lds_byte(wc * 32 + fr, fq * 8);
#define PG8_SA(b, h) (((b) * 2 + (h)) * HTB)
#define PG8_SB(b, h) ((4 + (b) * 2 + (h)) * HTB)
#define PG8_STAGE(bufoff, gbase, voff) do { _Pragma("unroll") for (int _i = 0; _i < 2; ++_i) \
        __builtin_amdgcn_global_load_lds((const unsigned*)((const char*)(gbase) + (voff)[_i]), (PG8_LAS unsigned*)(lds + (bufoff) + ldsw + _i * 8192), 16, 0, 0); } while (0)
#define PG8_LDA(dst, b, h) do { _Pragma("unroll") for (int m = 0; m < 4; ++m) _Pragma("unroll") for (int k = 0; k < 2; ++k) dst[m][k] = *(const PG8_LAS bf16x8*)(lds + PG8_SA(b, h) + aoff + m * 2048 + k * 1024); } while (0)
#define PG8_LDB(dst, b, h) do { _Pragma("unroll") for (int n = 0; n < 2; ++n) _Pragma("unroll") for (int k = 0; k < 2; ++k) dst[n][k] = *(const PG8_LAS bf16x8*)(lds + PG8_SB(b, h) + boff + n * 2048 + k * 1024); } while (0)
#define PG8_MMA(ai, bj, At, Bt) do { __builtin_amdgcn_s_setprio(1); _Pragma("unroll") for (int m = 0; m < 4; ++m) _Pragma("unroll") for (int n = 0; n < 2; ++n) _Pragma("unroll") for (int k = 0; k < 2; ++k) \
        acc[ai][bj][m][n] = __builtin_amdgcn_mfma_f32_16x16x32_bf16(Bt[n][k], At[m][k], acc[ai][bj][m][n], 0, 0, 0); __builtin_amdgcn_s_setprio(0); } while (0)
#define PG8_WAIT_V(n) asm volatile("s_waitcnt vmcnt(" #n ")" ::: "memory")
#define PG8_WAIT_L(n) asm volatile("s_waitcnt lgkmcnt(" #n ")" ::: "memory")
#define PG8_BAR __builtin_amdgcn_s_barrier()
#define PG8_SCHED __builtin_amdgcn_sched_barrier(0)
    Unit cur, nxt; int ui = 0;
    if (!S.next(0, cur)) return;
    f32x4 acc[2][2][4][2];
#pragma unroll
    for (int a = 0; a < 2; ++a)
#pragma unroll
        for (int b = 0; b < 2; ++b)
#pragma unroll
            for (int m = 0; m < 4; ++m)
#pragma unroll
                for (int n = 0; n < 2; ++n) acc[a][b][m][n] = (f32x4){0.f, 0.f, 0.f, 0.f};
    bf16x8 At[4][2], B0[2][2], B1[2][2];
    const char* cA = (const char*)g.A + (size_t)cur.pm * tstep; const char* cB = (const char*)g.Bt + (size_t)cur.pn * tstep;
    S.a_ready(cur);
    if constexpr (SP2) {
        PG8_STAGE(PG8_SB(0, 0), cB, voffB); PG8_STAGE(PG8_SB(0, 1), cB + hstep, voffB); PG8_STAGE(PG8_SA(0, 0), cA, voffA); PG8_STAGE(PG8_SA(0, 1), cA + hstep, voffA);
        if (wr == 1) PG8_BAR;
        PG8_WAIT_V(2); PG8_BAR;
        PG8_STAGE(PG8_SB(1, 0), cB + kstep, voffB); PG8_STAGE(PG8_SA(1, 0), cA + kstep, voffA); PG8_STAGE(PG8_SB(1, 1), cB + hstep + kstep, voffB);
        PG8_WAIT_V(6); PG8_BAR;
    } else {
        PG8_STAGE(PG8_SB(0, 0), cB, voffB); PG8_STAGE(PG8_SA(0, 0), cA, voffA); PG8_STAGE(PG8_SB(0, 1), cB + hstep, voffB); PG8_STAGE(PG8_SA(0, 1), cA + hstep, voffA);
        if (wr == 1) PG8_BAR;
        PG8_WAIT_V(4); PG8_BAR;
        PG8_STAGE(PG8_SB(1, 0), cB + kstep, voffB); PG8_STAGE(PG8_SA(1, 0), cA + kstep, voffA); PG8_STAGE(PG8_SB(1, 1), cB + hstep + kstep, voffB);
        PG8_WAIT_V(6); PG8_BAR;
    }
    for (;;) {
        const bool has_next = S.next(ui + 1, nxt);
        const char* nA = has_next ? (const char*)g.A + (size_t)nxt.pm * tstep : cA; const char* nB = has_next ? (const char*)g.Bt + (size_t)nxt.pn * tstep : cB;
        for (int t = 0; t < nt * (1 + PROBE_KLOOP2); t += 2) {
            const bool last = (t == nt * (1 + PROBE_KLOOP2) - 2);
            const char* a1 = cA + (size_t)((t + 1) % nt) * kstep;
            const char* a2 = last ? nA : cA + (size_t)((t + 2) % nt) * kstep; const char* b2 = last ? nB : cB + (size_t)((t + 2) % nt) * kstep;
            const char* a3 = a2 + kstep; const char* b3 = b2 + kstep;
            if (last && has_next) S.a_ready(nxt);
            if constexpr (SP2) {
            PG8_LDB(B0, 0, 0); PG8_LDB(B1, 0, 1); PG8_SCHED; PG8_LDA(At, 0, 0); PG8_STAGE(PG8_SA(1, 1), a1 + hstep, voffA);
            PG8_WAIT_V(8); PG8_WAIT_L(0); PG8_BAR; PG8_MMA(0, 0, At, B0); PG8_MMA(0, 1, At, B1); PG8_BAR; PG8_SCHED;
            PG8_LDA(At, 0, 1); PG8_STAGE(PG8_SB(0, 0), b2, voffB); PG8_STAGE(PG8_SB(0, 1), b2 + hstep, voffB); PG8_STAGE(PG8_SA(0, 0), a2, voffA);
            PG8_WAIT_V(8); PG8_WAIT_L(0); PG8_BAR; PG8_MMA(1, 0, At, B0); PG8_MMA(1, 1, At, B1); PG8_BAR; PG8_SCHED;
            PG8_LDB(B0, 1, 0); PG8_LDB(B1, 1, 1); PG8_SCHED; PG8_LDA(At, 1, 0); PG8_STAGE(PG8_SA(0, 1), a2 + hstep, voffA);
            PG8_WAIT_V(8); PG8_WAIT_L(0); PG8_BAR; PG8_MMA(0, 0, At, B0); PG8_MMA(0, 1, At, B1); PG8_BAR; PG8_SCHED;
            PG8_LDA(At, 1, 1); PG8_STAGE(PG8_SB(1, 0), b3, voffB); PG8_STAGE(PG8_SB(1, 1), b3 + hstep, voffB); PG8_STAGE(PG8_SA(1, 0), a3, voffA);
            PG8_WAIT_V(8); PG8_WAIT_L(0); PG8_BAR; PG8_MMA(1, 0, At, B0); PG8_MMA(1, 1, At, B1); PG8_BAR; PG8_SCHED;
            } else {
            PG8_LDB(B0, 0, 0); PG8_SCHED; PG8_LDA(At, 0, 0); PG8_STAGE(PG8_SA(1, 1), a1 + hstep, voffA);
            PG8_WAIT_L(8); PG8_BAR; PG8_WAIT_L(0); PG8_MMA(0, 0, At, B0); PG8_BAR; PG8_SCHED;
            PG8_LDB(B1, 0, 1); PG8_STAGE(PG8_SB(0, 0), b2, voffB);
            PG8_BAR; PG8_WAIT_L(0); PG8_MMA(0, 1, At, B1); PG8_BAR;
            PG8_LDA(At, 0, 1); PG8_STAGE(PG8_SA(0, 0), a2, voffA);
            PG8_BAR; PG8_WAIT_L(0); PG8_MMA(1, 0, At, B0); PG8_BAR; PG8_SCHED;
            PG8_STAGE(PG8_SB(0, 1), b2 + hstep, voffB);
            PG8_WAIT_V(6); PG8_BAR; PG8_MMA(1, 1, At, B1); PG8_BAR;
            PG8_LDB(B0, 1, 0); PG8_SCHED; PG8_LDA(At, 1, 0); PG8_STAGE(PG8_SA(0, 1), a2 + hstep, voffA);
            PG8_WAIT_L(8); PG8_BAR; PG8_WAIT_L(0); PG8_MMA(0, 0, At, B0); PG8_BAR; PG8_SCHED;
            PG8_LDB(B1, 1, 1); PG8_STAGE(PG8_SB(1, 0), b3, voffB);
            PG8_BAR; PG8_WAIT_L(0); PG8_MMA(0, 1, At, B1); PG8_BAR;
            PG8_LDA(At, 1, 1); PG8_STAGE(PG8_SA(1, 0), a3, voffA);
            PG8_BAR; PG8_WAIT_L(0); PG8_MMA(1, 0, At, B0); PG8_BAR; PG8_SCHED;
            PG8_STAGE(PG8_SB(1, 1), b3 + hstep, voffB);
            PG8_WAIT_V(6); PG8_BAR; PG8_MMA(1, 1, At, B1); PG8_BAR;
            }
        }
        if constexpr (ALIGN_EPI) { if (wr == 0) PG8_BAR; }
#if PROBE_KLOOP2
        _Pragma("unroll") for (int a = 0; a < 2; ++a) _Pragma("unroll") for (int b = 0; b < 2; ++b) _Pragma("unroll") for (int m = 0; m < 4; ++m) _Pragma("unroll") for (int n = 0; n < 2; ++n) acc[a][b][m][n] *= 0.5f;
#endif
        if constexpr (!Epi::AFTER_DRAIN) { E(acc, cur, wr, wc, fr, fq);
#if PROBE_EPI2
            asm volatile("" ::: "memory"); E(acc, cur, wr, wc, fr, fq);
#endif
            S.done(cur); }
        if (!has_next) break;
#pragma unroll
        for (int a = 0; a < 2; ++a)
#pragma unroll
            for (int b = 0; b < 2; ++b)
#pragma unroll
                for (int m = 0; m < 4; ++m)
#pragma unroll
                    for (int n = 0; n < 2; ++n) acc[a][b][m][n] = (f32x4){0.f, 0.f, 0.f, 0.f};
        cur = nxt; cA = nA; cB = nB; ++ui;
        if constexpr (ALIGN_EPI) { if (wr == 1) PG8_BAR; }
    }
    PG8_WAIT_V(0);
    if constexpr (!ALIGN_EPI) { if (wr == 0) PG8_BAR; }
    PG8_BAR;
    if constexpr (Epi::AFTER_DRAIN) { E.fused(acc, cur, wr, wc, fr, fq, lds, wid, lane); S.done(cur); }
#undef PG8_SA
#undef PG8_SB
#undef PG8_STAGE
#undef PG8_LDA
#undef PG8_LDB
#undef PG8_MMA
#undef PG8_WAIT_V
#undef PG8_WAIT_L
#undef PG8_BAR
#undef PG8_SCHED
}
}
namespace attn_body {
using bf16=__hip_bfloat16;
using bf16x8=__attribute__((ext_vector_type(8)))short;
using s16x4=__attribute__((ext_vector_type(4)))short;
using f32x16=__attribute__((ext_vector_type(16)))float;
using u32x4=__attribute__((ext_vector_type(4)))unsigned;
constexpr int BATCH=8,NHEAD=16,SEQ=4096,D=64,DM=NHEAD*D;
constexpr int NW=8,QBLK=32,QB=QBLK*NW,KVBLK=64,NQB=SEQ/QB;
constexpr int ATTN_PITCH=DM, ATTN_UNIT_ROWS=QB;
__device__ __forceinline__ int crow(int r,int hi){return (r&3)+8*(r>>2)+4*hi;}
#define SBAR() __builtin_amdgcn_sched_barrier(0)
__device__ __forceinline__ void cmask(f32x16&p0,f32x16&p1,int jb,int qrel,int hi){
  const float NEG=-INFINITY; int kb=64*jb+4*hi;
  #pragma unroll
  for(int r=0;r<16;++r){int kv=kb+(r&3)+8*(r>>2); if(kv>qrel)p0[r]=NEG; if(kv+32>qrel)p1[r]=NEG;}
}

constexpr int NSLOT=3, SLOTB=8192;
constexpr int LDS_K=0, LDS_V=NSLOT*SLOTB, LDS_WS=LDS_V+NSLOT*2*SLOTB, LDS_X=LDS_WS+NW*64*4  , LDS_BYTES=LDS_X+NW*8192, LDS_OST=0  ;
constexpr float C2=0.125f*1.4426950408889634f;
__device__ __forceinline__ void glds16(const void*gsrc,unsigned lds_dst){unsigned keep;
  asm volatile("s_mov_b32 %0, m0\n\ts_mov_b32 m0, %2\n\ts_nop 0\n\tglobal_load_lds_dwordx4 %1, off\n\ts_mov_b32 m0, %0":"=&s"(keep):"v"(gsrc),"s"(lds_dst):"memory");}
__device__ __forceinline__ float max3f(float a,float b,float c){float r;asm("v_max3_f32 %0, %1, %2, %3":"=v"(r):"v"(a),"v"(b),"v"(c));return r;}
__device__ __forceinline__ float max2f(float a,float b){float r;asm("v_max_f32_e32 %0, %1, %2":"=v"(r):"v"(a),"v"(b));return r;}
__device__ __forceinline__ float fadd_s(float a,float b){float r;asm("v_add_f32_e32 %0, %1, %2":"=v"(r):"v"(a),"v"(b));return r;}
__device__ __forceinline__ float fsub_s(float a,float b){float r;asm("v_sub_f32_e32 %0, %1, %2":"=v"(r):"v"(a),"v"(b));return r;}
typedef float f32x2_t __attribute__((ext_vector_type(2))); typedef __bf16 bf16x2_t __attribute__((ext_vector_type(2)));
__device__ __forceinline__ unsigned cvtpk_s(float lo,float hi){f32x2_t v={lo,hi};bf16x2_t b=__builtin_convertvector(v,bf16x2_t);return __builtin_bit_cast(unsigned,b);}
#define WAIT_BAR(N) asm volatile("s_waitcnt vmcnt(" #N ") lgkmcnt(0)\n\ts_barrier":::"memory")

__device__ __forceinline__ void qkt(f32x16&p0,f32x16&p1,const char*Kslot,const bf16x8*qr,const f32x16&negm,int r32,int hi){
  const char*kb=Kslot+hi*1024+r32*16;
  #pragma unroll
  for(int d0=0;d0<4;++d0){
    const bf16x8 b0=*reinterpret_cast<const bf16x8*>(kb+d0*2048);
    const bf16x8 b1=*reinterpret_cast<const bf16x8*>(kb+d0*2048+512);
    if(d0==0){p0=__builtin_amdgcn_mfma_f32_32x32x16_bf16(b0,qr[0],negm,0,0,0);p1=__builtin_amdgcn_mfma_f32_32x32x16_bf16(b1,qr[0],negm,0,0,0);}
    else{p0=__builtin_amdgcn_mfma_f32_32x32x16_bf16(b0,qr[d0],p0,0,0,0);p1=__builtin_amdgcn_mfma_f32_32x32x16_bf16(b1,qr[d0],p1,0,0,0);}}
}
typedef __attribute__((address_space(3))) const char* lds_cptr;
typedef short v4i16_t __attribute__((ext_vector_type(4)));
__device__ __forceinline__ void kload8(bf16x8*kf,lds_cptr kp){
  kf[0]=*(const __attribute__((address_space(3))) bf16x8*)(kp);      kf[1]=*(const __attribute__((address_space(3))) bf16x8*)(kp+512);
  kf[2]=*(const __attribute__((address_space(3))) bf16x8*)(kp+2048); kf[3]=*(const __attribute__((address_space(3))) bf16x8*)(kp+2560);
  kf[4]=*(const __attribute__((address_space(3))) bf16x8*)(kp+4096); kf[5]=*(const __attribute__((address_space(3))) bf16x8*)(kp+4608);
  kf[6]=*(const __attribute__((address_space(3))) bf16x8*)(kp+6144); kf[7]=*(const __attribute__((address_space(3))) bf16x8*)(kp+6656);
}
__device__ __forceinline__ void kload2(bf16x8*kf,lds_cptr kp,int j){ kf[2*j]=*(const __attribute__((address_space(3))) bf16x8*)(kp+j*2048); kf[2*j+1]=*(const __attribute__((address_space(3))) bf16x8*)(kp+j*2048+512); }
__device__ __forceinline__ s16x4 vtr(lds_cptr p){ return __builtin_bit_cast(s16x4,__builtin_amdgcn_ds_read_tr16_b64_v4i16((__attribute__((address_space(3))) v4i16_t*)p)); }
__device__ __forceinline__ float rowmax(const f32x16&p0,const f32x16&p1){
  float a=max3f(p0[0],p0[1],p1[0]),b=max3f(p0[2],p0[3],p1[1]);a=max3f(a,p1[2],p1[3]);
  #pragma unroll
  for(int r=4;r<16;r+=4){a=max3f(a,p0[r],p0[r+1]);b=max3f(b,p0[r+2],p0[r+3]);a=max3f(a,p1[r],p1[r+1]);b=max3f(b,p1[r+2],p1[r+3]);}
  const float m=max2f(a,b);
  auto rr=__builtin_amdgcn_permlane32_swap(__float_as_uint(m),__float_as_uint(m),false,false);
  return max2f(__uint_as_float(rr[0]),__uint_as_float(rr[1]));
}
__device__ __forceinline__ void pv(f32x16*o,int vb,bf16x8 pa0,bf16x8 pa1,bf16x8 pa2,bf16x8 pa3){
  #pragma unroll
  for(int d0=0;d0<4;++d0){s16x4 lo[4],hi[4];
    #pragma unroll
    for(int ks=0;ks<4;++ks){
      asm volatile("ds_read_b64_tr_b16 %0,%1 offset:%c2":"=&v"(lo[ks]):"v"(vb),"i"(d0*4096+ks*1024):"memory");
      asm volatile("ds_read_b64_tr_b16 %0,%1 offset:%c2":"=&v"(hi[ks]):"v"(vb),"i"(d0*4096+ks*1024+512):"memory");}
    asm volatile("s_waitcnt lgkmcnt(0)":::"memory");SBAR();
    #define PK(k) (bf16x8){lo[k][0],lo[k][1],lo[k][2],lo[k][3],hi[k][0],hi[k][1],hi[k][2],hi[k][3]}
    o[d0]=__builtin_amdgcn_mfma_f32_32x32x16_bf16(pa0,PK(0),o[d0],0,0,0);
    o[d0]=__builtin_amdgcn_mfma_f32_32x32x16_bf16(pa1,PK(1),o[d0],0,0,0);
    o[d0]=__builtin_amdgcn_mfma_f32_32x32x16_bf16(pa2,PK(2),o[d0],0,0,0);
    o[d0]=__builtin_amdgcn_mfma_f32_32x32x16_bf16(pa3,PK(3),o[d0],0,0,0);
    #undef PK
  }
}

#ifndef ATTN_STORE16
#define ATTN_STORE16(p,v) (*(u32x4*)(p)=(v))
#endif
typedef volatile __attribute__((address_space(3))) unsigned long long* diff_rec_t;
struct DiffEpi {
  static __device__ __forceinline__ void run(diff_rec_t rec,int pass,float*stg,unsigned*xs,const f32x16(&o)[4],const float*wsf,int row0,int lane,int r32,int hi){
    typedef float f32x4 __attribute__((ext_vector_type(4)));
    const float* subln=(const float*)rec[1]; const bf16* gate=(const bf16*)rec[2]; bf16* Yo=(bf16*)rec[3];
    const unsigned long long lw=rec[4]; const float lam=__uint_as_float((unsigned)lw), li1=__uint_as_float((unsigned)(lw>>32));
    float rli[16];
    #pragma unroll
    for(int r=0;r<16;++r)rli[r]=__builtin_amdgcn_rcpf(wsf[32+crow(r,hi)]);
    f32x4 da[4][2],db[4][2]; float ss[2]={0.f,0.f};
    u32x4 gvv[4][2]; f32x4 sav[4],sbv[4];
    if(pass==1){
      #pragma unroll
      for(int g=0;g<4;++g){ sav[g]=*(const f32x4*)(subln+g*32+(lane&3)*8); sbv[g]=*(const f32x4*)(subln+g*32+(lane&3)*8+4);
        #pragma unroll
        for(int i=0;i<2;++i) gvv[g][i]=*(const u32x4*)(gate+(long)(row0+i*16+(lane>>2))*DM+g*32+(lane&3)*8); }
    }
    #pragma unroll
    for(int g=0;g<4;++g){
      #pragma unroll
      for(int r=0;r<16;++r)stg[crow(r,hi)*32+r32]=o[g][r]*rli[r];
      asm volatile("s_waitcnt lgkmcnt(0)":::"memory");
      #pragma unroll
      for(int i=0;i<2;++i){ const int row=i*16+(lane>>2),ch=lane&3; const f32x4 va=*(const f32x4*)(stg+row*32+ch*8),vb=*(const f32x4*)(stg+row*32+ch*8+4);
        unsigned* xp=xs+((2*g+i)*64+lane)*4;
        if(pass==0){ u32x4 w; w[0]=cvtpk_s(va[0],va[1]); w[1]=cvtpk_s(va[2],va[3]); w[2]=cvtpk_s(vb[0],vb[1]); w[3]=cvtpk_s(vb[2],vb[3]); *(u32x4*)xp=w; }
        else if(pass==1){ const u32x4 w=*(const u32x4*)xp; f32x4 xa,xb; xa[0]=__uint_as_float(w[0]<<16); xa[1]=__uint_as_float(w[0]&0xffff0000u); xa[2]=__uint_as_float(w[1]<<16); xa[3]=__uint_as_float(w[1]&0xffff0000u);
          xb[0]=__uint_as_float(w[2]<<16); xb[1]=__uint_as_float(w[2]&0xffff0000u); xb[2]=__uint_as_float(w[3]<<16); xb[3]=__uint_as_float(w[3]&0xffff0000u);
          da[g][i]=xa-lam*va; db[g][i]=xb-lam*vb;
          #pragma unroll
          for(int k=0;k<4;++k) ss[i]+=da[g][i][k]*da[g][i][k]+db[g][i][k]*db[g][i][k]; }
      }
      asm volatile("s_waitcnt lgkmcnt(0)":::"memory");
    }
    if(pass==1){
      #pragma unroll
      for(int i=0;i<2;++i){ ss[i]+=__builtin_bit_cast(float,__builtin_amdgcn_update_dpp(0,__builtin_bit_cast(int,ss[i]),0xB1,0xF,0xF,true));
        ss[i]+=__builtin_bit_cast(float,__builtin_amdgcn_update_dpp(0,__builtin_bit_cast(int,ss[i]),0x4E,0xF,0xF,true));
        ss[i]=li1/sqrtf(ss[i]*(1.0f/128.0f)+1e-6f); }
      #pragma unroll
      for(int g=0;g<4;++g)
        #pragma unroll
        for(int i=0;i<2;++i){ const int row=i*16+(lane>>2),ch=lane&3; const long ro=(long)(row0+row)*DM+g*32+ch*8;
          const u32x4 gv=gvv[g][i]; const f32x4 sa=sav[g],sb=sbv[g];
          float y[8];
          #pragma unroll
          for(int k=0;k<4;++k){ y[k]=da[g][i][k]*ss[i]*sa[k]; y[4+k]=db[g][i][k]*ss[i]*sb[k]; }
          u32x4 w;
          #pragma unroll
          for(int k=0;k<4;++k){ const float ga=__uint_as_float(gv[k]<<16),gb=__uint_as_float(gv[k]&0xffff0000u);
            w[k]=cvtpk_s(y[2*k]*(ga/(1.0f+__expf(-ga))),y[2*k+1]*(gb/(1.0f+__expf(-gb)))); }
          *(u32x4*)(Yo+ro)=w; }
    }
  }
};
template<int THRL> __device__ __forceinline__ void attn_unit(int q0,const bf16*Qb,const bf16*__restrict__ Kh,const bf16*__restrict__ Vh,char*shm,int pass){
  int tid_=threadIdx.x; asm volatile("":"+v"(tid_));
  const int tid=tid_,lane=tid&63,r32=lane&31,hi=lane>>5; const int wid=__builtin_amdgcn_readfirstlane(tid>>6);
  const bf16*Qw=Qb+(long)(q0+wid*QBLK)*DM;
#if DIAG_MODE>=10 && DIAG_MODE<20
  const unsigned long long dg_in=__builtin_amdgcn_s_memtime();
#endif
  const unsigned lds0=(unsigned)(uintptr_t)shm;
  float*wsf=(float*)(shm+LDS_WS)+wid*64;
  const bf16*ksrc=Kh+(long)lane*DM+wid*8;
  const bf16*vsrc=Vh+(long)(16*(wid&3)+(lane>>2))*DM+(wid>>2)*32+(lane&3)*8;
  const unsigned kdst=lds0+LDS_K+wid*1024, vdst=lds0+LDS_V+wid*1024;
  #define DMA_K(t,slot) glds16(ksrc+(long)(t)*KVBLK*DM,(unsigned)__builtin_amdgcn_readfirstlane(kdst+(slot)))
  #define DMA_V(t,slot) do{ glds16(vsrc+(long)(t)*KVBLK*DM,(unsigned)__builtin_amdgcn_readfirstlane(vdst+2*(slot))); glds16(vsrc+(long)(t)*KVBLK*DM+64,(unsigned)__builtin_amdgcn_readfirstlane(vdst+2*(slot)+8192)); }while(0)
  const int vb0=(int)(lds0+LDS_V)+((lane>>4)&1)*32+(lane&3)*8+(4*hi+((lane&15)>>2))*64;
  const char*Kbase=shm+LDS_K; bf16x8 kf[8];
  const lds_cptr shm3=(lds_cptr)shm; const lds_cptr kp0=shm3+LDS_K+hi*1024+r32*16; const lds_cptr vp0=shm3+LDS_V+((lane>>4)&1)*32+(lane&3)*8+(4*hi+((lane&15)>>2))*64;
  const int NT=(q0+QB)/KVBLK;
  DMA_K(0,0);DMA_V(0,0);DMA_K(1,SLOTB);
  bf16x8 qr[4];
  #pragma unroll
  for(int d0=0;d0<4;++d0)qr[d0]=*reinterpret_cast<const bf16x8*>(&Qw[(long)r32*DM+d0*16+hi*8]);
  float mhat=0.f,l_reg=0.f;float z0_=0.f; asm volatile("":"+v"(z0_));     f32x16 o[4]; _Pragma("unroll") for(int d_=0;d_<4;++d_) _Pragma("unroll") for(int r=0;r<16;++r)o[d_][r]=z0_;f32x16 negm=f32x16{};asm volatile("":"+v"(negm));
  const int qrel=wid*QBLK+r32;
  #define CMASK(P0,P1,t) do{int jb_=(t)-(NT-4); if(jb_>=0)cmask(P0,P1,jb_,qrel,hi);}while(0)
  bool resc=false;
  #define START(P0,P1) do{ const float rm=rowmax(P0,P1); resc=false; \
    { const float dl=rm; mhat=fadd_s(mhat,dl); \
      _Pragma("unroll") for(int r=0;r<16;++r){P0[r]=fsub_s(P0[r],dl);P1[r]=fsub_s(P1[r],dl);} \
      _Pragma("unroll") for(int r=0;r<16;++r)negm[r]=-mhat; asm volatile("":"+v"(negm)); } \
    _Pragma("unroll") for(int r=0;r<16;++r)P0[r]=__builtin_amdgcn_exp2f(P0[r]); }while(0)
  #define RESC() do{ if(resc){ asm volatile("s_waitcnt lgkmcnt(0)":::"memory"); \
      _Pragma("unroll") for(int d_=0;d_<4;++d_) _Pragma("unroll") for(int r=0;r<16;++r)o[d_][r]*=wsf[crow(r,hi)]; } }while(0)
  f32x16 pA0,pA1,pB0,pB1;
  int sl_prev=0,sl_cur=0,sl_next=SLOTB;
  #define ROT() do{sl_prev=sl_cur;sl_cur=sl_next;sl_next=(sl_next==(NSLOT-1)*SLOTB)?0:sl_next+SLOTB;}while(0)
  DMA_K(2,2*SLOTB);
  WAIT_BAR(4);
  qkt(pA0,pA1,Kbase,qr,negm,r32,hi);asm volatile("s_nop 15\n\ts_nop 7":"+v"(pA0),"+v"(pA1));CMASK(pA0,pA1,0);
  START(pA0,pA1);
  _Pragma("unroll") for(int r=0;r<16;++r)pA1[r]=__builtin_amdgcn_exp2f(pA1[r]);
  WAIT_BAR(0);
  DMA_K(3,0);DMA_V(1,SLOTB);
  ROT();
  kload8(kf,kp0+sl_cur);
  WAIT_BAR(3);
  s16x4 vlo[16],vhi[16]; u32x4 pw0,pw1,pw2,pw3;
#if DIAG_MODE>=3 && DIAG_MODE<20
  unsigned long long dg_prev=__builtin_amdgcn_s_memtime(),dg_sum=0ull; unsigned dg_cnt=0u;
  #define DG_SEG(k) do{ SBAR(); const unsigned long long n_=__builtin_amdgcn_s_memtime(); if(DIAG_MODE==3+(k)) dg_sum+=n_-dg_prev; dg_prev=n_; SBAR(); }while(0)
  #define DG_CNT() do{ ++dg_cnt; }while(0)
#else
  #define DG_SEG(k) do{}while(0)
  #define DG_CNT() do{}while(0)
#endif
  #define PKW(P,B) cvtpk_s(P[B],P[B+1])
  #define PAF(k) __builtin_bit_cast(bf16x8,pw##k)
  #define VFR(i) (bf16x8){vlo[i][0],vlo[i][1],vlo[i][2],vlo[i][3],vhi[i][0],vhi[i][1],vhi[i][2],vhi[i][3]}
  #define PIN(x) asm volatile("":"+v"(x))
  #define MX3(a,b,c) __builtin_fmaxf(__builtin_fmaxf((a),(b)),(c))
  #define GAPA(MF,A0,A1,A2,A3,W0,W1,PW) do{ MF; sacc+=A0; sacc+=A1; sacc+=A2; sacc+=A3; PIN(sacc); W0; W1; PIN(PW); SBAR(); }while(0)
  #define EX(v) __builtin_amdgcn_exp2f(v)
  #define GAPM(MF,OPS) do{ MF; OPS; PIN(mxa_); PIN(mxb_); SBAR(); }while(0)
  #define EXI(X0,X1,e) do{ if((e)<16) X0[(e)&15]=EX(X0[(e)&15]); else X1[(e)&15]=EX(X1[(e)&15]); }while(0)
  #define GAPB3(MF,X0,X1,e0,e1,e2) do{ MF; EXI(X0,X1,e0); EXI(X0,X1,e1); EXI(X0,X1,e2); PIN(X0); PIN(X1); SBAR(); }while(0)
  #define GAPB2(MF,X0,X1,e0,e1) do{ MF; EXI(X0,X1,e0); EXI(X0,X1,e1); PIN(X0); PIN(X1); SBAR(); }while(0)
  #define VRD(j) do{ vlo[j]=vtr(vp_+(((j)&3)*4096+((j)>>2)*1024)); vhi[j]=vtr(vp_+(((j)&3)*4096+((j)>>2)*1024+512)); SBAR(); }while(0)
  #define PVM(j,k) o[(j)&3]=__builtin_amdgcn_mfma_f32_32x32x16_bf16(PAF(k),VFR(j),o[(j)&3],0,0,0)
  #define KRD(G,j) do{ if(G){ kload2(kf,kp0+sl_next,j); SBAR(); } }while(0)
  #define STEP(C0,C1,P0,P1,t,GK,GV,GL) do{ SBAR(); DG_SEG(3); DG_CNT(); \
    const lds_cptr vp_=vp0+2*sl_prev; \
    float sacc=(P0[0]+P0[1]); \
    GAPA(C0=__builtin_amdgcn_mfma_f32_32x32x16_bf16(kf[0],qr[0],negm,0,0,0), P0[2],P0[3],P0[4],P0[5],     pw0[0]=PKW(P0,0), pw0[1]=PKW(P0,2), pw0); \
    GAPA(C1=__builtin_amdgcn_mfma_f32_32x32x16_bf16(kf[1],qr[0],negm,0,0,0), P0[6],P0[7],P0[8],P0[9],     pw0[2]=PKW(P0,4), pw0[3]=PKW(P0,6), pw0); \
    GAPA(C0=__builtin_amdgcn_mfma_f32_32x32x16_bf16(kf[2],qr[1],C0,0,0,0),   P0[10],P0[11],P0[12],P0[13], pw1[0]=PKW(P0,8), pw1[1]=PKW(P0,10), pw1); \
    GAPA(C1=__builtin_amdgcn_mfma_f32_32x32x16_bf16(kf[3],qr[1],C1,0,0,0),   P0[14],P0[15],P1[0],P1[1],   pw1[2]=PKW(P0,12),pw1[3]=PKW(P0,14), pw1); \
    VRD(0); GAPA(C0=__builtin_amdgcn_mfma_f32_32x32x16_bf16(kf[4],qr[2],C0,0,0,0),   P1[2],P1[3],P1[4],P1[5],     pw2[0]=PKW(P1,0), pw2[1]=PKW(P1,2), pw2); \
    VRD(1); GAPA(C1=__builtin_amdgcn_mfma_f32_32x32x16_bf16(kf[5],qr[2],C1,0,0,0),   P1[6],P1[7],P1[8],P1[9],     pw2[2]=PKW(P1,4), pw2[3]=PKW(P1,6), pw2); \
    VRD(2); GAPA(C0=__builtin_amdgcn_mfma_f32_32x32x16_bf16(kf[6],qr[3],C0,0,0,0),   P1[10],P1[11],P1[12],P1[13], pw3[0]=PKW(P1,8), pw3[1]=PKW(P1,10), pw3); \
    VRD(3); GAPA(C1=__builtin_amdgcn_mfma_f32_32x32x16_bf16(kf[7],qr[3],C1,0,0,0),   P1[14],P1[15],0.f,0.f,       pw3[2]=PKW(P1,12),pw3[3]=PKW(P1,14), pw3); \
    l_reg+=sacc; DG_SEG(0); \
    if(GK){DMA_K((t)+3,sl_cur);} if(GV){DMA_V((t)+1,sl_next);} \
    CMASK(C0,C1,t); \
      \
    float mxa_,mxb_; \
    VRD(4);  GAPM(PVM(0,0), mxa_=MX3(C0[0],C0[1],C1[0]); mxb_=MX3(C0[2],C0[3],C1[1]); mxa_=MX3(mxa_,C1[2],C1[3]); mxa_=MX3(mxa_,C0[4],C0[5]); mxb_=MX3(mxb_,C0[6],C0[7])); \
    VRD(5);  GAPM(PVM(1,0), mxa_=MX3(mxa_,C1[4],C1[5]); mxb_=MX3(mxb_,C1[6],C1[7]); mxa_=MX3(mxa_,C0[8],C0[9]); mxb_=MX3(mxb_,C0[10],C0[11])); \
    VRD(6);  GAPM(PVM(2,0), mxa_=MX3(mxa_,C1[8],C1[9]); mxb_=MX3(mxb_,C1[10],C1[11]); mxa_=MX3(mxa_,C0[12],C0[13]); mxb_=MX3(mxb_,C0[14],C0[15])); \
    VRD(7);  GAPM(PVM(3,0), mxa_=MX3(mxa_,C1[12],C1[13]); mxb_=MX3(mxb_,C1[14],C1[15])); \
    { float rm=__builtin_fmaxf(mxa_,mxb_); { auto rr=__builtin_amdgcn_permlane32_swap(__float_as_uint(rm),__float_as_uint(rm),false,false); rm=__builtin_fmaxf(__uint_as_float(rr[0]),__uint_as_float(rr[1])); } \
      resc=false; \
      if(__builtin_expect(__any(rm>(float)THRL),0)){ const float dl=__builtin_fmaxf(rm,0.f); mhat+=dl; \
        _Pragma("unroll") for(int r=0;r<16;++r){C0[r]-=dl;C1[r]-=dl;} \
        _Pragma("unroll") for(int r=0;r<16;++r)negm[r]=-mhat; asm volatile("":"+v"(negm)); \
        const float f=__builtin_amdgcn_exp2f(-dl); l_reg*=f; if(hi==0)wsf[r32]=f; resc=true; } } \
    SBAR(); DG_SEG(1); \
    VRD(8);  GAPB3(PVM(4,1),C0,C1,0,1,2); \
    VRD(9);  KRD(GL,0); GAPB3(PVM(5,1),C0,C1,3,4,5); \
    VRD(10); GAPB3(PVM(6,1),C0,C1,6,7,8); \
    VRD(11); KRD(GL,1); GAPB3(PVM(7,1),C0,C1,9,10,11); \
    VRD(12); GAPB3(PVM(8,2),C0,C1,12,13,14); \
    VRD(13); KRD(GL,2); GAPB3(PVM(9,2),C0,C1,15,16,17); \
    VRD(14); GAPB3(PVM(10,2),C0,C1,18,19,20); \
    VRD(15); KRD(GL,3); GAPB3(PVM(11,2),C0,C1,21,22,23); \
    GAPB2(PVM(12,3),C0,C1,24,25); \
    GAPB2(PVM(13,3),C0,C1,26,27); \
    GAPB2(PVM(14,3),C0,C1,28,29); \
    GAPB2(PVM(15,3),C0,C1,30,31); DG_SEG(2); \
    }while(0)
#if DIAG_MODE==11
  const unsigned long long dg_p=__builtin_amdgcn_s_memtime()-dg_in;
#endif
  int t=1;
  #undef CMASK
  #define CMASK(P0,P1,t) do{}while(0)
  for(;t+5<NT;t+=2){
    STEP(pB0,pB1,pA0,pA1,t,true,true,true);     WAIT_BAR(3); RESC(); ROT();
    STEP(pA0,pA1,pB0,pB1,t+1,true,true,true);   WAIT_BAR(3); RESC(); ROT();
  }
  #undef CMASK
  #define CMASK(P0,P1,t) do{int jb_=(t)-(NT-4); if(jb_>=0)cmask(P0,P1,jb_,qrel,hi);}while(0)
  #define ENDW(tt) do{ if((tt)+3<NT){WAIT_BAR(3);} else if((tt)+2<NT){WAIT_BAR(2);} else {WAIT_BAR(0);} }while(0)
  for(;t+1<NT;t+=2){
    STEP(pB0,pB1,pA0,pA1,t,(t+3<NT),(t+1<NT),(t+1<NT));       ENDW(t);   RESC(); ROT();
    STEP(pA0,pA1,pB0,pB1,t+1,(t+4<NT),(t+2<NT),(t+2<NT));     ENDW(t+1); RESC(); ROT();
  }
  STEP(pB0,pB1,pA0,pA1,NT-1,false,false,false); RESC();
  { float sacc=pB0[0]+pB0[1]; _Pragma("unroll") for(int r=2;r<16;++r)sacc+=pB0[r]; _Pragma("unroll") for(int r=0;r<16;++r)sacc+=pB1[r]; l_reg+=sacc;
    pw0=(u32x4){PKW(pB0,0),PKW(pB0,2),PKW(pB0,4),PKW(pB0,6)};pw1=(u32x4){PKW(pB0,8),PKW(pB0,10),PKW(pB0,12),PKW(pB0,14)};pw2=(u32x4){PKW(pB1,0),PKW(pB1,2),PKW(pB1,4),PKW(pB1,6)};pw3=(u32x4){PKW(pB1,8),PKW(pB1,10),PKW(pB1,12),PKW(pB1,14)};
    SBAR(); pv(o,vb0+2*sl_cur,PAF(0),PAF(1),PAF(2),PAF(3)); }
  #undef PKW
  #undef PAF
  #undef VFR
  #undef PIN
  #undef MX3
  #undef GAPA
  #undef GAPB
  #undef EX
  #undef VRD
  #undef KRD
  #undef PVM
  #undef GAPM
  #undef EXI
  #undef GAPB3
  #undef GAPB2
  #undef STEP
  #undef ENDW
#if DIAG_MODE==8
  const unsigned long long dg_e0=__builtin_amdgcn_s_memtime();
#endif
#if DIAG_MODE>=3 && DIAG_MODE<8
  { diff_rec_t rc_=(diff_rec_t)((__attribute__((address_space(3))) char*)shm3+LDS_BYTES+wid*64); if(lane==0){ rc_[5]=rc_[5]+dg_sum; rc_[6]=rc_[6]+(unsigned long long)dg_cnt; } }
#endif
  {auto rr=__builtin_amdgcn_permlane32_swap(__float_as_uint(l_reg),__float_as_uint(l_reg),false,false);l_reg=__uint_as_float(rr[0])+__uint_as_float(rr[1]);}
  if(hi==0)wsf[32+r32]=l_reg;asm volatile("s_waitcnt lgkmcnt(0)\n\ts_barrier":::"memory");
  DiffEpi::run((diff_rec_t)((__attribute__((address_space(3))) char*)shm3+LDS_BYTES+wid*64),pass,(float*)(shm+LDS_OST)+wid*1024,(unsigned*)(shm+LDS_X)+wid*2048,o,wsf,q0+wid*QBLK,lane,r32,hi);
  asm volatile("s_waitcnt lgkmcnt(0)\n\ts_barrier":::"memory");
#if DIAG_MODE==8
  { diff_rec_t rc_=(diff_rec_t)((__attribute__((address_space(3))) char*)shm3+LDS_BYTES+wid*64); if(lane==0){ rc_[5]=rc_[5]+(__builtin_amdgcn_s_memtime()-dg_e0)/4ull; rc_[6]=rc_[6]+1ull; } }
#endif
#if DIAG_MODE==10
  { diff_rec_t rc_=(diff_rec_t)((__attribute__((address_space(3))) char*)shm3+LDS_BYTES+wid*64); if(lane==0){ rc_[5]=rc_[5]+(__builtin_amdgcn_s_memtime()-dg_in)/64ull; rc_[6]=rc_[6]+1ull; } }
#endif
#if DIAG_MODE==11
  { diff_rec_t rc_=(diff_rec_t)((__attribute__((address_space(3))) char*)shm3+LDS_BYTES+wid*64); if(lane==0){ rc_[5]=rc_[5]+dg_p/4ull; rc_[6]=rc_[6]+1ull; } }
#endif
  #undef DMA_K
  #undef DMA_V
  #undef CMASK
  #undef START
  #undef RESC
  #undef ROT
}
#undef SBAR
#undef WAIT_BAR
}

namespace win {
using attn_body::bf16; using attn_body::bf16x8; using attn_body::s16x4; using attn_body::f32x16; using attn_body::u32x4; using attn_body::lds_cptr;
using attn_body::glds16; using attn_body::vtr; using attn_body::cvtpk_s; using attn_body::crow;
constexpr int LK = 0, LV = 49152, LQ = 98304, LWS = 131072, LOST = 133120, WIN_LDS_BYTES = 149504;
struct Unit { int g, bh, rho0, first; };
#define WIN_WAITV(n) do { if ((n) == 4) asm volatile("s_waitcnt vmcnt(4)" ::: "memory"); else if ((n) == 6) asm volatile("s_waitcnt vmcnt(6)" ::: "memory"); else if ((n) == 8) asm volatile("s_waitcnt vmcnt(8)" ::: "memory"); \
    else if ((n) == 9) asm volatile("s_waitcnt vmcnt(9)" ::: "memory"); else if ((n) == 10) asm volatile("s_waitcnt vmcnt(10)" ::: "memory"); else if ((n) == 11) asm volatile("s_waitcnt vmcnt(11)" ::: "memory"); \
    else asm volatile("s_waitcnt vmcnt(0)" ::: "memory"); } while (0)
#define WIN_BAR() asm volatile("s_waitcnt lgkmcnt(0)\n\ts_barrier" ::: "memory")
template <bool COMBINE, class Dec>
__device__ __forceinline__ void phase(int ub, int ue, const Dec& dec, char* shm) {
    if (ub >= ue) return;
    constexpr int NST = COMBINE ? 4 : 5;
    int tid_ = threadIdx.x; asm volatile("" : "+v"(tid_));
    const int tid = tid_, lane = tid & 63, r32 = lane & 31, hi = lane >> 5; const int wid = __builtin_amdgcn_readfirstlane(tid >> 6);
    const unsigned lds0 = (unsigned)(uintptr_t)shm; const lds_cptr shm3 = (lds_cptr)shm;
    float* wsf = (float*)(shm + LWS) + wid * 64;
    const int koff = wid * 512 + lane * 8, voff = wid * 512 + lane * 8, qoff = wid * 2048 + lane * 8;
#define WIN_ISSUE_K(U) do { const bf16* ks_ = dec.K(U) + (long)((U).rho0 - 128) * 64 + koff; for (int t_ = (U).first ? 2 : 0; t_ < 6; ++t_) glds16(ks_ + (long)t_ * 4096, (unsigned)__builtin_amdgcn_readfirstlane(lds0 + LK + t_ * 8192 + wid * 1024)); } while (0)
#define WIN_ISSUE_V(U) do { const bf16* vs_ = dec.V(U) + (long)((U).rho0 - 128) * 64 + voff; for (int t_ = (U).first ? 2 : 0; t_ < 6; ++t_) glds16(vs_ + (long)t_ * 4096, (unsigned)__builtin_amdgcn_readfirstlane(lds0 + LV + t_ * 8192 + wid * 1024)); } while (0)
#define WIN_ISSUE_Q(U) do { const bf16* qs_ = dec.Q(U) + (long)(U).rho0 * 64 + qoff; _Pragma("unroll") for (int p_ = 0; p_ < 4; ++p_) glds16(qs_ + p_ * 512, (unsigned)__builtin_amdgcn_readfirstlane(lds0 + LQ + wid * 4096 + p_ * 1024)); } while (0)
#if DIAG_MODE>=30 && DIAG_MODE<40
    volatile unsigned long long* wgd = (volatile unsigned long long*)(shm + WIN_LDS_BYTES + wid * 32);
    if (!COMBINE && lane == 0) { wgd[0] = __builtin_amdgcn_s_memtime(); wgd[1] = 0ull; wgd[2] = 0ull; }
  #define WG_SEG(k) do{ __builtin_amdgcn_sched_barrier(0); if (!COMBINE && lane == 0) { const unsigned long long n_=__builtin_amdgcn_s_memtime(); if(DIAG_MODE==30+(k)) wgd[1]=wgd[1]+(n_-wgd[0]); wgd[0]=n_; } __builtin_amdgcn_sched_barrier(0); }while(0)
#else
  #define WG_SEG(k) do{}while(0)
#endif
    Unit cur = dec.unit(ub);
    WIN_ISSUE_K(cur); WIN_ISSUE_Q(cur); WIN_ISSUE_V(cur);
    for (int u = ub; u < ue; ++u) {
        const bool has_next = (u + 1 < ue);
        Unit nxt = cur; if (has_next) nxt = dec.unit(u + 1);
        const int np_cur = cur.first ? 4 : 6, np_nxt = has_next ? (nxt.first ? 4 : 6) : 0;
        WG_SEG(5);
        WIN_WAITV(u == ub ? np_cur : np_cur + NST); WIN_BAR();
        WG_SEG(0);
        bf16x8 qr[4];
        { const lds_cptr qb = shm3 + LQ + wid * 4096 + hi * 512 + r32 * 16;
#pragma unroll
          for (int d0 = 0; d0 < 4; ++d0) qr[d0] = *(const __attribute__((address_space(3))) bf16x8*)(qb + d0 * 1024); }
        f32x16 S[5];
        const int jlo = cur.first ? (4 - wid > 0 ? 4 - wid : 0) : 0;
#define WIN_KLD(dst, j_) do { const int bk_ = wid + (j_); const lds_cptr kb_ = shm3 + LK + (bk_ >> 1) * 8192 + (bk_ & 1) * 512 + hi * 1024 + r32 * 16; \
        _Pragma("unroll") for (int d0 = 0; d0 < 4; ++d0) dst[d0] = *(const __attribute__((address_space(3))) bf16x8*)(kb_ + d0 * 2048); } while (0)
        bf16x8 kfa[4];
#pragma unroll
        for (int j = 0; j < 5; ++j) {
            if (j >= jlo) {
                WIN_KLD(kfa, j);
                f32x16 a = {};
#pragma unroll
                for (int d0 = 0; d0 < 4; ++d0) a = __builtin_amdgcn_mfma_f32_32x32x16_bf16(kfa[d0], qr[d0], a, 0, 0, 0);
                S[j] = a;
            } else {
#pragma unroll
                for (int r = 0; r < 16; ++r) S[j][r] = -INFINITY;
            }
        }
#undef WIN_KLD
        WIN_BAR();
        WG_SEG(1);
        u32x4 pv1[2][2], pv2[2][2], pgv[2][2]; float pl1[2], pl2[2];
        if (COMBINE) {
            const int rw0_ = cur.rho0 + wid * 32;
#pragma unroll
            for (int i = 0; i < 2; ++i) { const int s = rw0_ + i * 16 + (lane >> 2), ch = lane & 3; const int rho1 = ((s & 3) << 10) + (s >> 2), rho2 = ((s & 15) << 8) + (s >> 4);
                pl1[i] = dec.L1h(cur)[rho1]; pl2[i] = dec.L2h(cur)[rho2];
#pragma unroll
                for (int d0 = 0; d0 < 2; ++d0) {
                    pv1[d0][i] = *(const u32x4*)(dec.O1h(cur) + (long)rho1 * 64 + d0 * 32 + ch * 8); pv2[d0][i] = *(const u32x4*)(dec.O2h(cur) + (long)rho2 * 64 + d0 * 32 + ch * 8);
                    pgv[d0][i] = *(const u32x4*)(dec.gate(cur) + (long)s * 1024 + d0 * 32 + ch * 8); } }
        }
        if (has_next) { WIN_ISSUE_K(nxt); WIN_ISSUE_Q(nxt); }
#pragma unroll
        for (int r = 0; r < 16; ++r) { const int kk = crow(r, hi); if (kk < r32) S[0][r] = -INFINITY; if (kk > r32) S[4][r] = -INFINITY; }
        float mx = S[4][0];
#pragma unroll
        for (int j = 0; j < 5; ++j)
#pragma unroll
            for (int r = 0; r < 16; ++r) mx = fmaxf(mx, S[j][r]);
        mx = fmaxf(mx, __shfl_xor(mx, 32));
        float l = 0.f;
#pragma unroll
        for (int j = 0; j < 5; ++j)
#pragma unroll
            for (int r = 0; r < 16; ++r) { const float p = __builtin_amdgcn_exp2f(S[j][r] - mx); S[j][r] = p; l += p; }
        l += __shfl_xor(l, 32);
        WG_SEG(2);
        WIN_WAITV(has_next ? np_nxt + 4 : 0); WIN_BAR();
        WG_SEG(3);
        f32x16 o[2]; o[0] = f32x16{}; o[1] = f32x16{};
        const unsigned vb0 = (unsigned)(uintptr_t)shm + LV + ((lane >> 4) & 1) * 32 + (lane & 3) * 8 + (4 * hi + ((lane & 15) >> 2)) * 64;
#pragma unroll
        for (int j = 0; j < 5; ++j) {
            if (j >= jlo) {
                const int bk = wid + j; const unsigned vt = vb0 + (bk >> 1) * 8192 + (bk & 1) * 2048;
                s16x4 vl[4], vh[4];
#pragma unroll
                for (int q = 0; q < 4; ++q) {
                    asm volatile("ds_read_b64_tr_b16 %0,%1 offset:%c2" : "=&v"(vl[q]) : "v"(vt), "i"((q & 1) * 4096 + (q >> 1) * 1024) : "memory");
                    asm volatile("ds_read_b64_tr_b16 %0,%1 offset:%c2" : "=&v"(vh[q]) : "v"(vt), "i"((q & 1) * 4096 + (q >> 1) * 1024 + 512) : "memory"); }
                u32x4 pw[2];
#pragma unroll
                for (int s2 = 0; s2 < 2; ++s2) { pw[s2][0] = cvtpk_s(S[j][8 * s2 + 0], S[j][8 * s2 + 1]); pw[s2][1] = cvtpk_s(S[j][8 * s2 + 2], S[j][8 * s2 + 3]); pw[s2][2] = cvtpk_s(S[j][8 * s2 + 4], S[j][8 * s2 + 5]); pw[s2][3] = cvtpk_s(S[j][8 * s2 + 6], S[j][8 * s2 + 7]); }
                asm volatile("s_waitcnt lgkmcnt(0)" : "+v"(vl[0]), "+v"(vl[1]), "+v"(vl[2]), "+v"(vl[3]), "+v"(vh[0]), "+v"(vh[1]), "+v"(vh[2]), "+v"(vh[3]) :: "memory"); __builtin_amdgcn_sched_barrier(0);
#pragma unroll
                for (int q = 0; q < 4; ++q) {
                    const bf16x8 vf = (bf16x8){vl[q][0], vl[q][1], vl[q][2], vl[q][3], vh[q][0], vh[q][1], vh[q][2], vh[q][3]};
                    o[q & 1] = __builtin_amdgcn_mfma_f32_32x32x16_bf16(__builtin_bit_cast(bf16x8, pw[q >> 1]), vf, o[q & 1], 0, 0, 0); }
            }
        }
        WIN_BAR();
        WG_SEG(4);
        if (COMBINE) {
#pragma unroll
            for (int d0 = 0; d0 < 2; ++d0)
#pragma unroll
                for (int i = 0; i < 2; ++i) asm volatile("" : "+v"(pv1[d0][i]), "+v"(pv2[d0][i]), "+v"(pgv[d0][i]));
            asm volatile("" : "+v"(pl1[0]), "+v"(pl1[1]), "+v"(pl2[0]), "+v"(pl2[1]));
        }
        if (has_next) WIN_ISSUE_V(nxt);
        if (hi == 0) { wsf[32 + r32] = l; wsf[r32] = mx + __builtin_amdgcn_logf(l); }
        asm volatile("s_waitcnt lgkmcnt(0)" ::: "memory");
        bf16* stg = (bf16*)(shm + LOST) + wid * 1024;
        const int rw0 = cur.rho0 + wid * 32;
#pragma unroll
        for (int d0 = 0; d0 < 2; ++d0) {
#pragma unroll
            for (int r = 0; r < 16; ++r) stg[crow(r, hi) * 32 + r32] = __float2bfloat16(o[d0][r] * __builtin_amdgcn_rcpf(wsf[32 + crow(r, hi)]));
            asm volatile("s_waitcnt lgkmcnt(0)" ::: "memory");
#pragma unroll
            for (int i = 0; i < 2; ++i) {
                const int row = i * 16 + (lane >> 2), ch = lane & 3; const u32x4 v0 = *(const u32x4*)(stg + row * 32 + ch * 8);
                if (!COMBINE) { *(u32x4*)(dec.Opart(cur) + (long)(rw0 + row) * 64 + d0 * 32 + ch * 8) = v0; }
                else {
                    const int s = rw0 + row;
                    const float l0 = wsf[row], l1 = pl1[i], l2 = pl2[i];
                    const u32x4 v1 = pv1[d0][i], v2 = pv2[d0][i], gv = pgv[d0][i];
                    const float mm = fmaxf(l0, fmaxf(l1, l2));
                    float e0 = __builtin_amdgcn_exp2f(l0 - mm), e1 = __builtin_amdgcn_exp2f(l1 - mm), e2 = __builtin_amdgcn_exp2f(l2 - mm);
                    const float inv = 1.0f / (e0 + e1 + e2); e0 *= inv; e1 *= inv; e2 *= inv;
                    u32x4 ov;
#pragma unroll
                    for (int k = 0; k < 4; ++k) {
                        float y[2];
#pragma unroll
                        for (int hh = 0; hh < 2; ++hh) {
                            const float a0 = __uint_as_float(hh ? (v0[k] & 0xffff0000u) : (v0[k] << 16)), a1 = __uint_as_float(hh ? (v1[k] & 0xffff0000u) : (v1[k] << 16)), a2 = __uint_as_float(hh ? (v2[k] & 0xffff0000u) : (v2[k] << 16));
                            const float g = __uint_as_float(hh ? (gv[k] & 0xffff0000u) : (gv[k] << 16));
                            const float oc = e0 * a0 + e1 * a1 + e2 * a2;
                            y[hh] = oc * (g / (1.0f + __expf(-g)));
                        }
                        ov[k] = cvtpk_s(y[0], y[1]);
                    }
                    *(u32x4*)(dec.Yp(cur) + (long)s * 1024 + d0 * 32 + ch * 8) = ov;
                }
            }
            asm volatile("s_waitcnt lgkmcnt(0)" ::: "memory");
        }
        if (!COMBINE) { if (hi == 0) dec.lsepart(cur)[rw0 + r32] = wsf[r32]; }
        cur = nxt;
#if DIAG_MODE>=30 && DIAG_MODE<40
        if (!COMBINE && lane == 0) wgd[2] = wgd[2] + 1ull;
#endif
    }
#if DIAG_MODE>=30 && DIAG_MODE<40
    if (!COMBINE && wid == 0 && lane == 0) { const unsigned long long c_ = wgd[2]; wsf[0] = (float)wgd[1] / (float)(c_ ? c_ : 1ull) * 0.125f; }
#endif
    asm volatile("s_waitcnt vmcnt(0) lgkmcnt(0)\n\ts_barrier" ::: "memory");
#undef WIN_ISSUE_K
#undef WIN_ISSUE_V
#undef WIN_ISSUE_Q
}
#undef WIN_WAITV
#undef WIN_BAR
}

constexpr int NWAVES = 8;
constexpr int BATCH = 8, SEQ = 4096, D = 1024, M = BATCH * SEQ;
constexpr int N0A = 6144, N0B = 4096, N1 = 4096;
constexpr float RMS_EPS = 1e-6f;
constexpr float QSCALE = 0.125f * 1.4426950408889634f;
constexpr int N_PHASES = 11;
#ifndef PROBE_EPI2
#define PROBE_EPI2 0
#endif
#ifndef PROBE_P5DUMMY
#define PROBE_P5DUMMY 0
#endif
#ifndef GEMM_STAGGER_TICKS
#define GEMM_STAGGER_TICKS 0
#endif
#ifndef PROBE_X2
#define PROBE_X2 0
#endif
#ifndef PROBE_REP
#define PROBE_REP 0
#endif

constexpr size_t MiB = 1u << 20;
constexpr size_t WS_CTL = 0, CTL_ZERO_BYTES = 1 * MiB;
constexpr size_t WS_ROPE = 1 * MiB;
constexpr size_t WS_LSE = 2 * MiB;
constexpr size_t WS_W0 = 8 * MiB, WS_WO0 = 28 * MiB, WS_W1 = 30 * MiB, WS_WO1 = 38 * MiB;
constexpr size_t WS_U = 40 * MiB;
constexpr size_t WS_PROJ = 104 * MiB, SEC_BYTES = 64 * MiB;
constexpr size_t SEC_ELEMS = SEC_BYTES / 2;
constexpr size_t WS_Y = WS_PROJ + 4 * SEC_BYTES;
constexpr size_t WS_T = WS_PROJ + 5 * SEC_BYTES;
constexpr size_t WS_END = 488 * MiB;
constexpr int CW_TMO = 0, CW_CODE = 1, CW_DIAG = 64, CW_BAR = 4096;

constexpr int RING_OFF = 0, RING_BYTES = 149504;
constexpr int LDSCTL_OFF = RING_BYTES, MISC_OFF = LDSCTL_OFF + 320;
constexpr int LDS_BYTES = 153600;
static_assert(MISC_OFF + 128 <= LDS_BYTES && pg8::STAGE_BYTES <= RING_BYTES && win::WIN_LDS_BYTES <= RING_BYTES && attn_body::LDS_BYTES + 512 <= RING_BYTES, "LDS map");

#define GAS __attribute__((address_space(1)))
#define LAS __attribute__((address_space(3)))
typedef unsigned short bf16;
typedef unsigned v4u __attribute__((ext_vector_type(4)));
typedef float f32x4 __attribute__((ext_vector_type(4)));
typedef short bf16x8 __attribute__((ext_vector_type(8)));
typedef GAS unsigned gu32;
typedef GAS unsigned long long gu64;
#define RLX_AGENT __ATOMIC_RELAXED, __HIP_MEMORY_SCOPE_AGENT
#define LDS_WAIT() asm volatile("s_waitcnt lgkmcnt(0)" ::: "memory")
#define VM_WAIT() asm volatile("s_waitcnt vmcnt(0)" ::: "memory")
__device__ __forceinline__ unsigned long long rt() { return __builtin_amdgcn_s_memrealtime(); }
__device__ __forceinline__ unsigned f2bf(float f) { unsigned u = __builtin_bit_cast(unsigned, f); return (u + 0x7fffu + ((u >> 16) & 1u)) >> 16; }
__device__ __forceinline__ unsigned pk2(float lo, float hi) { return f2bf(lo) | (f2bf(hi) << 16); }

#define XB_TMO      128
#define XB_XCNT(j)  (256  + 64 * (j))
#define XB_XSUB(j)  (1280 + 64 * (j))
#define XB_XGEN(j)  (2304 + 64 * (j))
#define XB_TOP      3328
#define XB_TOPGEN   3392
#define XCD_BAR_WORDS 3456
#define XB_SPIN_CAP (1u << 18)

__device__ __forceinline__ unsigned xb_ld(unsigned* p)              { return __hip_atomic_load(p, __ATOMIC_RELAXED, __HIP_MEMORY_SCOPE_AGENT); }
__device__ __forceinline__ unsigned xb_add(unsigned* p, unsigned v) { return __hip_atomic_fetch_add(p, v, __ATOMIC_RELAXED, __HIP_MEMORY_SCOPE_AGENT); }
__device__ __forceinline__ unsigned xb_xcc_id() { return (unsigned)__builtin_amdgcn_s_getreg((3 << 11) | 20) & 0xFu; }
#define XB_SPIN(cond, bar) do { unsigned _sp = 0; while (cond) { __builtin_amdgcn_s_sleep(1); \
    if ((++_sp & 255u) == 0u) { if (xb_ld(&(bar)[XB_TMO])) break; if (_sp > XB_SPIN_CAP) { atomicAdd(&(bar)[XB_TMO], 1u); break; } } } } while (0)

struct XcdBarrier {
    unsigned* bar; unsigned x;
    volatile LAS unsigned* st;
};

__device__ __forceinline__ XcdBarrier xcd_barrier_post(unsigned* bar, volatile LAS unsigned* st) {
    XcdBarrier b; b.bar = bar; b.x = xb_xcc_id(); b.st = st;
    if (threadIdx.x == 0) (void)xb_add(&bar[XB_XCNT(b.x)], 1u);
    return b;
}
__device__ __forceinline__ void xcd_barrier_complete(unsigned* bar, unsigned x, unsigned& nloc, unsigned& nx) {
    const unsigned G = gridDim.x * gridDim.y * gridDim.z;
    unsigned sum, cnt, mine, sp = 0u;
    for (;;) {
        sum = 0u; cnt = 0u; mine = 0u;
#pragma unroll
        for (unsigned j = 0; j < 16; ++j) { const unsigned c = xb_ld(&bar[XB_XCNT(j)]); sum += c; cnt += (c > 0u) ? 1u : 0u; mine = (j == x) ? c : mine; }
        if (sum == G) break;
        __builtin_amdgcn_s_sleep(1);
        if ((++sp & 255u) == 0u) { if (xb_ld(&bar[XB_TMO])) break; if (sp > XB_SPIN_CAP) { atomicAdd(&bar[XB_TMO], 1u); break; } }
    }
    nloc = mine > 0u ? mine : 1u; nx = cnt > 0u ? cnt : 1u;
}

__device__ __forceinline__ void xcd_barrier(const XcdBarrier& b) {
    asm volatile("s_waitcnt vmcnt(0)" ::: "memory");
    __syncthreads();
    if (threadIdx.x == 0) {
        unsigned* bar = b.bar;
        __builtin_amdgcn_s_waitcnt(0);
        unsigned nloc = b.st[0], nx = b.st[1];
        if (nloc == 0u) { xcd_barrier_complete(bar, b.x, nloc, nx); b.st[0] = nloc; b.st[1] = nx; }
        const unsigned old = xb_add(&bar[XB_XSUB(b.x)], 1u);
        const unsigned gen = old / nloc;
        if (old + 1u == (gen + 1u) * nloc) {
            __builtin_amdgcn_fence(__ATOMIC_RELEASE, "agent");
            asm volatile("s_waitcnt vmcnt(0)" ::: "memory");
            const unsigned og = xb_add(&bar[XB_TOP], 1u);
            const unsigned tg = og / nx;
            if (og + 1u == (tg + 1u) * nx) xb_add(&bar[XB_TOPGEN], 1u);
            else XB_SPIN(xb_ld(&bar[XB_TOPGEN]) == tg, bar);
            __builtin_amdgcn_fence(__ATOMIC_ACQUIRE, "agent");
            xb_add(&bar[XB_XGEN(b.x)], 1u);
            asm volatile("s_waitcnt vmcnt(0)" ::: "memory");
        } else {
            XB_SPIN(xb_ld(&bar[XB_XGEN(b.x)]) == gen, bar);
            __builtin_amdgcn_fence(__ATOMIC_ACQUIRE, "agent");
            asm volatile("s_waitcnt vmcnt(0)" ::: "memory");
        }
    }
    __syncthreads();
}


struct Frame {
    LAS unsigned char* lds; volatile LAS unsigned* MISC; gu32* ctl;
    int tid, lane, wave, vcu, G;
};

#define WS_DPP(v, ctrl) ((v) + __builtin_bit_cast(float, __builtin_amdgcn_update_dpp(0, __builtin_bit_cast(int, (v)), (ctrl), 0xF, 0xF, true)))
__device__ __forceinline__ float wave_sum(float v) {
    v = WS_DPP(v, 0xB1); v = WS_DPP(v, 0x4E); v = WS_DPP(v, 0x141); v = WS_DPP(v, 0x140);
    { const auto r = __builtin_amdgcn_permlane16_swap(__float_as_uint(v), __float_as_uint(v), false, false); v = __uint_as_float(r[0]) + __uint_as_float(r[1]); }
    { const auto r = __builtin_amdgcn_permlane32_swap(__float_as_uint(v), __float_as_uint(v), false, false); v = __uint_as_float(r[0]) + __uint_as_float(r[1]); }
    return v;
}
__device__ __forceinline__ int map_rope64(int d) { return (d & 15) | ((d & 16) << 1) | ((d & 32) >> 1); }
__device__ __forceinline__ int map_plain32(int c) { return (c & ~31) | ((c & 4) << 2) | ((c & 24) >> 1) | (c & 3); }
template <int MODE> __device__ __forceinline__ int wrow(int c) {
    if (MODE == 2) return map_plain32(c);
    const int sec = c >> 10, wi = c & 1023;
    if (MODE == 1) return (sec << 10) + ((sec < 2) ? ((wi & ~63) | map_rope64(wi & 63)) : map_plain32(wi));
    const int dsec = (int)((0x9548327106ull >> (4 * sec)) & 15ull);
    return (dsec << 10) + ((sec < 6) ? ((wi & ~63) | map_rope64(wi & 63)) : map_plain32(wi));
}
template <int MODE> __device__ __forceinline__ void p0_transpose_item(const float* W, int K, int N, bf16* WT, LAS float* scr, int item, int lane) {
    const int nblk = N / 32, kb = item / nblk, nb = item % nblk, k0 = 64 * kb, n0 = 32 * nb;
#pragma unroll 8
    for (int i = 0; i < 32; ++i) { const int kk = 2 * i + (lane >> 5); scr[kk * 33 + (lane & 31)] = W[(size_t)(k0 + kk) * N + n0 + (lane & 31)]; }
    LDS_WAIT(); asm volatile("" ::: "memory");
    const int c = lane & 7;
#pragma unroll
    for (int j = 0; j < 4; ++j) { const int n = (lane >> 3) + 8 * j; const LAS float* s = scr + (8 * c) * 33 + n;
        v4u o; o.x = pk2(s[0 * 33], s[1 * 33]); o.y = pk2(s[2 * 33], s[3 * 33]); o.z = pk2(s[4 * 33], s[5 * 33]); o.w = pk2(s[6 * 33], s[7 * 33]);
        *(GAS v4u*)(WT + (size_t)wrow<MODE>(n0 + n) * K + k0 + 8 * c) = o; }
    LDS_WAIT(); asm volatile("" ::: "memory");
}
__device__ __forceinline__ f32x4 bf4_to_f32(unsigned long long w) { const unsigned lo = (unsigned)w, hi = (unsigned)(w >> 32); f32x4 r; r.x = __uint_as_float(lo << 16); r.y = __uint_as_float(lo & 0xffff0000u); r.z = __uint_as_float(hi << 16); r.w = __uint_as_float(hi & 0xffff0000u); return r; }
__device__ __forceinline__ unsigned long long f32_to_bf4(f32x4 v) { return (unsigned long long)pk2(v.x, v.y) | ((unsigned long long)pk2(v.z, v.w) << 32); }
__device__ __forceinline__ float ssq4(const f32x4 (&v)[4]) { float s = 0.f;
#pragma unroll
    for (int j = 0; j < 4; ++j) s += (v[j].x * v[j].x + v[j].y * v[j].y) + (v[j].z * v[j].z + v[j].w * v[j].w);
    return s; }
constexpr int RB = 4;
__device__ __forceinline__ void rms_rows_to_bf16(const float* x, const float* g, bf16* U, int gw, int NGW, int lane) {
    f32x4 gv[4];
#pragma unroll
    for (int j = 0; j < 4; ++j) gv[j] = ((const GAS f32x4*)g + lane)[64 * j];
    const bool ctg_ = (M % NGW) == 0; const int rpw_ = M / NGW;
    for (int m0 = ctg_ ? gw * rpw_ : gw, me_ = ctg_ ? (gw + 1) * rpw_ : M; m0 < me_; m0 += ctg_ ? RB : RB * NGW) {
        f32x4 v[RB][4];
#pragma unroll
        for (int r = 0; r < RB; ++r) { const int m = m0 + (ctg_ ? r : r * NGW); if (m < me_) {
#pragma unroll
            for (int j = 0; j < 4; ++j) v[r][j] = ((const GAS f32x4*)(x + (size_t)m * D) + lane)[64 * j]; } }
#pragma unroll
        for (int r = 0; r < RB; ++r) { const int m = m0 + (ctg_ ? r : r * NGW); if (m < me_) {
            const float rs = 1.f / sqrtf(wave_sum(ssq4(v[r])) * (1.f / D) + RMS_EPS);
            GAS unsigned long long* o8 = (GAS unsigned long long*)(U + (size_t)m * D) + lane;
#pragma unroll
            for (int j = 0; j < 4; ++j) o8[64 * j] = f32_to_bf4(v[r][j] * rs * gv[j]); } }
    }
}
__device__ __forceinline__ void post_rows0(const float* x, bf16* T_h, const float* gpost, const float* gpre, bf16* U, int gw, int NGW, int lane) {
    f32x4 gp4[4], gq4[4];
#pragma unroll
    for (int j = 0; j < 4; ++j) { gp4[j] = ((const GAS f32x4*)gpost + lane)[64 * j]; gq4[j] = ((const GAS f32x4*)gpre + lane)[64 * j]; }
    const bool ctg_ = (M % NGW) == 0; const int rpw_ = M / NGW;
    for (int m0 = ctg_ ? gw * rpw_ : gw, me_ = ctg_ ? (gw + 1) * rpw_ : M; m0 < me_; m0 += ctg_ ? RB : RB * NGW) {
        f32x4 b[RB][4]; unsigned long long tw[RB][4];
#pragma unroll
        for (int r = 0; r < RB; ++r) { const int m = m0 + (ctg_ ? r : r * NGW); if (m < me_) {
#pragma unroll
            for (int j = 0; j < 4; ++j) { b[r][j] = ((const GAS f32x4*)(x + (size_t)m * D) + lane)[64 * j]; tw[r][j] = ((const GAS unsigned long long*)(T_h + (size_t)m * D) + lane)[64 * j]; } } }
#pragma unroll
        for (int r = 0; r < RB; ++r) { const int m = m0 + (ctg_ ? r : r * NGW); if (m < me_) {
            f32x4 t[4];
#pragma unroll
            for (int j = 0; j < 4; ++j) t[j] = bf4_to_f32(tw[r][j]);
            const float rs = 1.f / sqrtf(wave_sum(ssq4(t)) * (1.f / D) + RMS_EPS);
            f32x4 h[4];
#pragma unroll
            for (int j = 0; j < 4; ++j) h[j] = b[r][j] + t[j] * rs * gp4[j];
            GAS unsigned long long* ho = (GAS unsigned long long*)(T_h + (size_t)m * D) + lane;
#pragma unroll
            for (int j = 0; j < 4; ++j) ho[64 * j] = f32_to_bf4(h[j]);
            const float r2 = 1.f / sqrtf(wave_sum(ssq4(h)) * (1.f / D) + RMS_EPS);
            GAS unsigned long long* o8 = (GAS unsigned long long*)(U + (size_t)m * D) + lane;
#pragma unroll
            for (int j = 0; j < 4; ++j) o8[64 * j] = f32_to_bf4(h[j] * r2 * gq4[j]); } }
    }
}
__device__ __forceinline__ void post_rows1(const bf16* H, const bf16* T1, const float* gpost, float* out, int gw, int NGW, int lane) {
    f32x4 gp4[4];
#pragma unroll
    for (int j = 0; j < 4; ++j) gp4[j] = ((const GAS f32x4*)gpost + lane)[64 * j];
    const bool ctg_ = (M % NGW) == 0; const int rpw_ = M / NGW;
    for (int m0 = ctg_ ? gw * rpw_ : gw, me_ = ctg_ ? (gw + 1) * rpw_ : M; m0 < me_; m0 += ctg_ ? RB : RB * NGW) {
        unsigned long long hw[RB][4], tw[RB][4];
#pragma unroll
        for (int r = 0; r < RB; ++r) { const int m = m0 + (ctg_ ? r : r * NGW); if (m < me_) {
#pragma unroll
            for (int j = 0; j < 4; ++j) { hw[r][j] = ((const GAS unsigned long long*)(H + (size_t)m * D) + lane)[64 * j]; tw[r][j] = ((const GAS unsigned long long*)(T1 + (size_t)m * D) + lane)[64 * j]; } } }
#pragma unroll
        for (int r = 0; r < RB; ++r) { const int m = m0 + (ctg_ ? r : r * NGW); if (m < me_) {
            f32x4 t[4];
#pragma unroll
            for (int j = 0; j < 4; ++j) t[j] = bf4_to_f32(tw[r][j]);
            const float rs = 1.f / sqrtf(wave_sum(ssq4(t)) * (1.f / D) + RMS_EPS);
            GAS f32x4* oo = (GAS f32x4*)(out + (size_t)m * D) + lane;
#pragma unroll
            for (int j = 0; j < 4; ++j) oo[64 * j] = bf4_to_f32(hw[r][j]) + t[j] * rs * gp4[j]; } }
    }
}

struct WinDecA {
    const bf16* proj; bf16* part; float* lse;
    __device__ __forceinline__ win::Unit unit(int u) const { win::Unit U; U.g = 1 + (u >> 11); const int idx = u & 2047; U.bh = idx >> 4; const int blk = idx & 15; U.rho0 = blk * 256; U.first = (U.g == 2) || ((blk & 3) == 0); return U; }
    __device__ __forceinline__ const win::bf16* Q(const win::Unit& U) const { return (const win::bf16*)(proj + (size_t)(U.g - 1) * SEC_ELEMS + (size_t)U.bh * 4096 * 64); }
    __device__ __forceinline__ const win::bf16* K(const win::Unit& U) const { return (const win::bf16*)(proj + (size_t)(U.g + 1) * SEC_ELEMS + (size_t)U.bh * 4096 * 64); }
    __device__ __forceinline__ const win::bf16* V(const win::Unit& U) const { return (const win::bf16*)(proj + (size_t)(U.g + 3) * SEC_ELEMS + (size_t)U.bh * 4096 * 64); }
    __device__ __forceinline__ win::bf16* Opart(const win::Unit& U) const { return (win::bf16*)(part + (size_t)(U.g - 1) * SEC_ELEMS + (size_t)U.bh * 4096 * 64); }
    __device__ __forceinline__ float* lsepart(const win::Unit& U) const { return lse + (size_t)(U.g - 1) * (128 * 4096) + (size_t)U.bh * 4096; }
    __device__ __forceinline__ const win::bf16* O1h(const win::Unit&) const { return nullptr; }
    __device__ __forceinline__ const win::bf16* O2h(const win::Unit&) const { return nullptr; }
    __device__ __forceinline__ const float* L1h(const win::Unit&) const { return nullptr; }
    __device__ __forceinline__ const float* L2h(const win::Unit&) const { return nullptr; }
    __device__ __forceinline__ const win::bf16* gate(const win::Unit&) const { return nullptr; }
    __device__ __forceinline__ win::bf16* Yp(const win::Unit&) const { return nullptr; }
};
struct WinDecB {
    const bf16* proj; const bf16* part; const float* lse; bf16* Y;
    __device__ __forceinline__ win::Unit unit(int u) const { win::Unit U; U.g = 0; U.bh = u >> 4; const int blk = u & 15; U.rho0 = blk * 256; U.first = (blk == 0); return U; }
    __device__ __forceinline__ const win::bf16* Q(const win::Unit& U) const { return (const win::bf16*)(proj + (size_t)U.bh * 4096 * 64); }
    __device__ __forceinline__ const win::bf16* K(const win::Unit& U) const { return (const win::bf16*)(proj + SEC_ELEMS + (size_t)U.bh * 4096 * 64); }
    __device__ __forceinline__ const win::bf16* V(const win::Unit& U) const { return (const win::bf16*)(proj + 2 * SEC_ELEMS + (size_t)U.bh * 4096 * 64); }
    __device__ __forceinline__ win::bf16* Opart(const win::Unit&) const { return nullptr; }
    __device__ __forceinline__ float* lsepart(const win::Unit&) const { return nullptr; }
    __device__ __forceinline__ const win::bf16* O1h(const win::Unit& U) const { return (const win::bf16*)(part + (size_t)U.bh * 4096 * 64); }
    __device__ __forceinline__ const win::bf16* O2h(const win::Unit& U) const { return (const win::bf16*)(part + SEC_ELEMS + (size_t)U.bh * 4096 * 64); }
    __device__ __forceinline__ const float* L1h(const win::Unit& U) const { return lse + (size_t)U.bh * 4096; }
    __device__ __forceinline__ const float* L2h(const win::Unit& U) const { return lse + (size_t)(128 * 4096) + (size_t)U.bh * 4096; }
    __device__ __forceinline__ const win::bf16* gate(const win::Unit& U) const { return (const win::bf16*)(proj + 3 * SEC_ELEMS + (size_t)(U.bh >> 4) * SEQ * D + (U.bh & 15) * 64); }
    __device__ __forceinline__ win::bf16* Yp(const win::Unit& U) const { return (win::bf16*)(Y + (size_t)(U.bh >> 4) * SEQ * D + (U.bh & 15) * 64); }
};
__device__ __forceinline__ void gemm_stagger(int vcu) {
    if (GEMM_STAGGER_TICKS > 0) { const unsigned long long t0 = rt(), w = (unsigned long long)(vcu & 3) * GEMM_STAGGER_TICKS; while (rt() - t0 < w) __builtin_amdgcn_s_sleep(8); }
}
struct Args { const float* in[12]; float* out; unsigned char* ws; int ph_lo, ph_hi; int rep, pad; };
__global__ void __launch_bounds__(NWAVES * 64, 2) mega_fwd(Args args) {
    extern __shared__ __attribute__((aligned(16))) unsigned char lds[];
    cg::grid_group grid = cg::this_grid();
    Frame F;
    F.lds = (LAS unsigned char*)lds; F.MISC = (volatile LAS unsigned*)(F.lds + MISC_OFF);
    F.tid = threadIdx.x; F.lane = F.tid & 63; F.wave = __builtin_amdgcn_readfirstlane(F.tid >> 6);
    F.G = gridDim.x; { const int bx = blockIdx.x; F.vcu = (F.G % 8 == 0) ? (bx % 8) * (F.G / 8) + bx / 8 : bx; }
    unsigned char* ws = args.ws;
    F.ctl = (gu32*)(ws + WS_CTL);
    const float* x = args.in[0]; const float* norm_pre = args.in[1]; const float* norm_post = args.in[2];
    const float* dil_w_in = args.in[3]; const float* dil_w_out = args.in[4]; const float* diff_w_in = args.in[5]; const float* diff_w_out = args.in[6];
    const float* lq1 = args.in[7]; const float* lk1 = args.in[8]; const float* lq2 = args.in[9]; const float* lk2 = args.in[10]; const float* subln = args.in[11];
    float* out = args.out;
    bf16* W0t = (bf16*)(ws + WS_W0); bf16* Wo0t = (bf16*)(ws + WS_WO0); bf16* W1t = (bf16*)(ws + WS_W1); bf16* Wo1t = (bf16*)(ws + WS_WO1);
    bf16* U = (bf16*)(ws + WS_U); bf16* PROJ = (bf16*)(ws + WS_PROJ); bf16* Y = (bf16*)(ws + WS_Y); bf16* T = (bf16*)(ws + WS_T);
    float* CS = (float*)(ws + WS_ROPE); float* LSE = (float*)(ws + WS_LSE);
    for (int u = F.tid; u < (LDS_BYTES - LDSCTL_OFF) / 4; u += NWAVES * 64) ((LAS unsigned*)(F.lds + LDSCTL_OFF))[u] = 0u;
    __syncthreads();
    XcdBarrier bar = xcd_barrier_post((unsigned*)(F.ctl + CW_BAR), F.MISC + 8);
    const int lo = args.ph_lo, hi = args.ph_hi;
    if (DIAG_MODE >= 20 && F.tid == 0) { const unsigned long long r_ = __builtin_amdgcn_s_memrealtime(); F.MISC[22] = (unsigned)r_; F.MISC[23] = (unsigned)(r_ >> 32); }
#define DIAG_PH(k) do { if (DIAG_MODE == 20 + (k) && blockIdx.x == 0 && F.tid == 0) { const unsigned long long r0_ = (unsigned long long)F.MISC[22] | ((unsigned long long)F.MISC[23] << 32); F.MISC[20] = __float_as_uint((float)(__builtin_amdgcn_s_memrealtime() - r0_) * 0.01f); } } while (0)
#define IN(k) (lo <= (k) && (k) < hi)
#define REP(k) for (int rr_ = 0; rr_ <= ((PROBE_REP >> (k)) & 1); ++rr_)
#define BOTH(k) (IN(k) && IN((k) + 1))
#define GRID_BAR() xcd_barrier(bar)
    const int gw = F.vcu * NWAVES + F.wave, NGW = F.G * NWAVES;

    if (IN(0)) {
        REP(0) {
        LAS float* scr = (LAS float*)(F.lds + RING_OFF + F.wave * 16384);
        constexpr int I_W0 = (D / 64) * (10240 / 32), I_WO = (D / 64) * (D / 32), I_W1 = (D / 64) * (N1 / 32);
        constexpr int NITEMS = I_W0 + 2 * I_WO + I_W1;
        for (int it = gw; it < NITEMS; it += NGW) {
            int r = it;
            if (r < I_W0) { p0_transpose_item<0>(dil_w_in, D, 10240, W0t, scr, r, F.lane); continue; } r -= I_W0;
            if (r < I_W1) { p0_transpose_item<1>(diff_w_in, D, N1, W1t, scr, r, F.lane); continue; } r -= I_W1;
            if (r < I_WO) { p0_transpose_item<2>(dil_w_out, D, D, Wo0t, scr, r, F.lane); continue; } r -= I_WO;
            p0_transpose_item<2>(diff_w_out, D, D, Wo1t, scr, r, F.lane);
        }
        rms_rows_to_bf16(x, norm_pre, U, gw, NGW, F.lane);
        }
        if (BOTH(0)) { if (args.ph_lo < 0) grid.sync();
                       else GRID_BAR(); }
        DIAG_PH(0);
    }
    if (IN(1)) {
        if (DIAG_MODE == 2 && F.tid == 0) { const unsigned long long c_ = __builtin_amdgcn_s_memtime(), r_ = __builtin_amdgcn_s_memrealtime(); F.MISC[16] = (unsigned)c_; F.MISC[17] = (unsigned)(c_ >> 32); F.MISC[18] = (unsigned)r_; F.MISC[19] = (unsigned)(r_ >> 32); }
        REP(1) {
        gemm_stagger(F.vcu);
        pg8::Gemm g{U, W0t, M, N0A, D}; pg8::StaticOrder S; S.init(M, N0A, F.G, (int)blockIdx.x, 1 + ((PROBE_X2 >> 1) & 1));
        pg8::EpiProj E{PROJ, SEC_ELEMS, 0x0fu, 0x03u, 0x3fu, 0x424242u, 0x0cu, CS, QSCALE};
        pg8::gemm_phase<pg8::EpiProj, pg8::StaticOrder, false, true>(F.lds + RING_OFF, g, S, E);
        }
        if (DIAG_MODE == 2 && blockIdx.x == 0 && F.tid == 0) { const unsigned long long dc0_ = (unsigned long long)F.MISC[16] | ((unsigned long long)F.MISC[17] << 32), dr0_ = (unsigned long long)F.MISC[18] | ((unsigned long long)F.MISC[19] << 32);
            const unsigned long long dc = __builtin_amdgcn_s_memtime() - dc0_, dr = __builtin_amdgcn_s_memrealtime() - dr0_; F.MISC[20] = __float_as_uint((float)dc / (float)dr * 100.0f - 1000.0f); }
        if (BOTH(1)) GRID_BAR();
        DIAG_PH(1);
    }
    if (IN(2)) {
        REP(2) {
        const int ub = (int)(((long)4096 * F.vcu) / F.G), ue = (int)(((long)4096 * (F.vcu + 1)) / F.G);
        const WinDecA dec{PROJ, (bf16*)out, LSE};
        win::phase<false, WinDecA>(ub, ue, dec, (char*)lds + RING_OFF);
        if (DIAG_MODE >= 30 && DIAG_MODE < 40 && blockIdx.x == 0 && F.tid == 0) F.MISC[20] = __float_as_uint(*(volatile LAS float*)(F.lds + RING_OFF + win::LWS));
        }
        if (BOTH(2)) GRID_BAR();
        DIAG_PH(2);
    }
    if (IN(3)) {
        REP(3) {
        gemm_stagger(F.vcu);
        pg8::Gemm g{U, W0t + (size_t)N0A * D, M, N0B, D}; pg8::StaticOrder S; S.init(M, N0B, F.G, (int)blockIdx.x, 1 + ((PROBE_X2 >> 3) & 1));
        pg8::EpiProj E{PROJ, SEC_ELEMS, 0x03u, 0x01u, 0x07u, 0x0u, 0x02u, CS, QSCALE};
        pg8::gemm_phase<pg8::EpiProj, pg8::StaticOrder, false, true>(F.lds + RING_OFF, g, S, E);
        }
        if (BOTH(3)) GRID_BAR();
        DIAG_PH(3);
    }
    if (IN(4)) {
        REP(4) {
        const int ub = (int)(((long)2048 * F.vcu) / F.G), ue = (int)(((long)2048 * (F.vcu + 1)) / F.G);
        const WinDecB dec{PROJ, (const bf16*)out, LSE, Y};
        win::phase<true, WinDecB>(ub, ue, dec, (char*)lds + RING_OFF);
        }
        if (BOTH(4)) GRID_BAR();
        DIAG_PH(4);
    }
    if (IN(5)) {
        REP(5) {
        pg8::Gemm g{Y, Wo0t, M, D, D}; pg8::StaticOrder S; S.init(M, D, F.G, (int)blockIdx.x, 1 + ((PROBE_X2 >> 5) & 1));
        pg8::EpiProj E{T, 0, 0u, 0u, 0u, 0u, 0u, CS, 1.0f};
        pg8::gemm_phase<pg8::EpiProj, pg8::StaticOrder, false, true>(F.lds + RING_OFF, g, S, E);
        }
        if (BOTH(5)) GRID_BAR();
        DIAG_PH(5);
    }
    if (IN(6)) {
        REP(6) {
        int t_ = threadIdx.x; asm volatile("" : "+v"(t_));
        post_rows0(x, T, norm_post, norm_pre + D, U, gw, NGW, t_ & 63);
        }
        if (BOTH(6)) GRID_BAR();
        DIAG_PH(6);
    }
    if (IN(7)) {
        REP(7) {
        gemm_stagger(F.vcu);
        pg8::Gemm g{U, W1t, M, N1, D}; pg8::StaticOrder S; S.init(M, N1, F.G, (int)blockIdx.x, 1 + ((PROBE_X2 >> 7) & 1));
        pg8::EpiProj E{PROJ, SEC_ELEMS, 0x03u, 0x01u, 0x0u, 0x0u, 0x0u, CS, QSCALE};
        pg8::gemm_phase<pg8::EpiProj, pg8::StaticOrder, false, true>(F.lds + RING_OFF, g, S, E);
        }
        if (BOTH(7)) GRID_BAR();
        DIAG_PH(7);
    }
    if (IN(8)) {
        unsigned long long dc0_ = 0, dr0_ = 0; if (DIAG_MODE == 1 || DIAG_MODE == 12 || DIAG_MODE == 13) { dc0_ = __builtin_amdgcn_s_memtime(); dr0_ = __builtin_amdgcn_s_memrealtime(); }
        REP(8) {
        int t_ = threadIdx.x; asm volatile("" : "+v"(t_)); const int ln_ = t_ & 63;
        float d1 = lq1[ln_] * lk1[ln_], d2 = lq2[ln_] * lk2[ln_]; d1 = wave_sum(d1); d2 = wave_sum(d2);
        const float lambda_init = 0.8f - 0.6f * 0.74081822068f;
        const float lam = __expf(d1) - __expf(d2) + lambda_init;
        attn_body::diff_rec_t rec = (attn_body::diff_rec_t)(F.lds + RING_OFF + attn_body::LDS_BYTES + F.wave * 64);
        rec[0] = 0ull; rec[1] = (unsigned long long)subln;
        rec[4] = (unsigned long long)__float_as_uint(lam) | ((unsigned long long)__float_as_uint(1.0f - lambda_init) << 32); rec[5] = 0ull; rec[6] = 0ull;
        const int nun = (F.G == 256) ? 4 : (1024 - F.vcu + F.G - 1) / F.G;
        for (int ii = 0; ii < nun * (1 + ((PROBE_X2 >> 8) & 1)); ++ii) {
            const int i = ii % nun; int bh, qb;
            if (F.G == 256) { const int s = F.vcu & 3; bh = F.vcu >> 2; qb = (i == 0) ? 15 - s : (i == 1) ? 8 + s : (i == 2) ? 7 - s : s; }
            else { const int u = F.vcu + i * F.G; bh = u >> 4; qb = 15 - (u & 15); }
            const int b = bh >> 3, h = bh & 7; const size_t bo = (size_t)b * SEQ * D;
            { unsigned ra_ = (unsigned)(RING_OFF + attn_body::LDS_BYTES) + (unsigned)F.wave * 64u; asm volatile("" : "+s"(ra_));
              attn_body::diff_rec_t rc_ = (attn_body::diff_rec_t)(F.lds + ra_);
              rc_[2] = (unsigned long long)(PROJ + 3 * SEC_ELEMS + bo + h * 128); rc_[3] = (unsigned long long)(Y + bo + h * 128); }
            for (int pp = 0; pp < 2 * (1 + PROBE_P5DUMMY); ++pp) {
                const bool dummy = PROBE_P5DUMMY && (pp & 1); const int c = dummy ? 4 : (PROBE_P5DUMMY ? (pp >> 1) : pp);
                attn_body::attn_unit<8>(dummy ? 0 : qb * 256, (const attn_body::bf16*)(PROJ + bo + (2 * h + (c & 1)) * 64), (const attn_body::bf16*)(PROJ + SEC_ELEMS + bo + (2 * h + (c & 1)) * 64),
                                        (const attn_body::bf16*)(PROJ + 2 * SEC_ELEMS + bo + h * 128), (char*)lds + RING_OFF, c);
            }
        }
        }
        if (DIAG_MODE >= 3 && DIAG_MODE < 12 && blockIdx.x == 0 && F.tid == 0) { attn_body::diff_rec_t rq_ = (attn_body::diff_rec_t)(F.lds + RING_OFF + attn_body::LDS_BYTES); const unsigned long long sm = rq_[5], cn = rq_[6]; F.MISC[20] = __float_as_uint((float)sm / (float)(cn ? cn : 1ull) * 0.5f); }
        if (DIAG_MODE == 1 && blockIdx.x == 0 && F.tid == 0) { const unsigned long long dc = __builtin_amdgcn_s_memtime() - dc0_, dr = __builtin_amdgcn_s_memrealtime() - dr0_; F.MISC[20] = __float_as_uint((float)dc / (float)dr * 100.0f - 1000.0f); }
        if (DIAG_MODE == 13 && blockIdx.x == 0 && F.tid == 0) F.MISC[20] = __float_as_uint((float)(__builtin_amdgcn_s_memrealtime() - dr0_) * 0.01f);
        if (BOTH(8)) GRID_BAR();
        DIAG_PH(8);
        if (DIAG_MODE == 12 && blockIdx.x == 0 && F.tid == 0) F.MISC[20] = __float_as_uint((float)(__builtin_amdgcn_s_memrealtime() - dr0_) * 0.01f);
    }
    if (IN(9)) {
        REP(9) {
        pg8::Gemm g{Y, Wo1t, M, D, D}; pg8::StaticOrder S; S.init(M, D, F.G, (int)blockIdx.x, 1 + ((PROBE_X2 >> 9) & 1));
        pg8::EpiProj E{PROJ, 0, 0u, 0u, 0u, 0u, 0u, CS, 1.0f};
        pg8::gemm_phase<pg8::EpiProj, pg8::StaticOrder, false, true>(F.lds + RING_OFF, g, S, E);
        }
        if (BOTH(9)) GRID_BAR();
        DIAG_PH(9);
    }
    if (IN(10)) {
        int t_ = threadIdx.x; asm volatile("" : "+v"(t_));
        post_rows1(T, PROJ, norm_post + D, out, gw, NGW, t_ & 63);
    }
    if (DIAG_MODE != 0 && blockIdx.x == 0 && F.tid == 0) { const unsigned long long t0 = rt(), w = (unsigned long long)(__uint_as_float(F.MISC[20]) * 100.0f); while (rt() - t0 < w) __builtin_amdgcn_s_sleep(10); }
#undef IN
#undef BOTH
#undef GRID_BAR
}

static int launch_mega(void* const* d_in, void* d_out, void* d_ws, size_t ws_size, hipStream_t stream, int ph_lo, int ph_hi, int rep) {
    static int grid = 0;
    if (grid == 0) {
        if (ws_size < WS_END) { fprintf(stderr, "kernel_launch: needs %zu bytes of workspace, got %zu; nothing launched\n", (size_t)WS_END, ws_size); grid = -1; return -1; }
        int dev = 0, cus = 0, per_cu = 0;
        if (hipGetDevice(&dev) != hipSuccess || hipDeviceGetAttribute(&cus, hipDeviceAttributeMultiprocessorCount, dev) != hipSuccess) { grid = -1; return -1; }
        if (hipFuncSetAttribute((const void*)mega_fwd, hipFuncAttributeMaxDynamicSharedMemorySize, LDS_BYTES) != hipSuccess) { fprintf(stderr, "kernel_launch: hipFuncSetAttribute failed\n"); grid = -1; return -1; }
        if (hipOccupancyMaxActiveBlocksPerMultiprocessor(&per_cu, (const void*)mega_fwd, NWAVES * 64, LDS_BYTES) != hipSuccess || per_cu < 1) { fprintf(stderr, "kernel_launch: occupancy query says %d blocks per CU\n", per_cu); (void)hipGetLastError(); grid = -1; return -1; }
        grid = cus;
    }
    if (grid < 0) return -1;
    if (hipMemsetAsync((char*)d_ws + WS_CTL, 0, CTL_ZERO_BYTES, stream) != hipSuccess) return -1;
    Args a{};
    for (int i = 0; i < 12; ++i) a.in[i] = (const float*)d_in[i];
    a.out = (float*)d_out; a.ws = (unsigned char*)d_ws; a.ph_lo = ph_lo; a.ph_hi = ph_hi; a.rep = rep;
    void* kargs[] = {&a};
    const hipError_t e = hipLaunchCooperativeKernel((const void*)mega_fwd, dim3(grid), dim3(NWAVES * 64), kargs, LDS_BYTES, stream);
    if (e != hipSuccess) { fprintf(stderr, "kernel_launch: cooperative launch failed: %s (grid %d)\n", hipGetErrorString(e), grid); return -1; }
    return 0;
}
extern "C" void kernel_launch(void* const* d_in, const int* in_sizes, int n_in, void* d_out, int out_size, void* d_ws, size_t ws_size, hipStream_t stream) {
    (void)in_sizes; (void)n_in; (void)out_size;
    launch_mega(d_in, d_out, d_ws, ws_size, stream, 0, N_PHASES, PROBE_REP);
}
```
